# Optimizing an MI355X kernel written in HIP

```python
import math
import jax
import jax.numpy as jnp
from jax import lax
import numpy as np

D_MODEL = 1024
BATCH = 4
SEQ = 4096
DEPTH = 2
DEC_BATCH = 2
DEC_SEQ = 16384
PAST_LEN = 128

HEAD_DIM = 64
N_DIFF_HEADS = 4
DIFF_WIDTH = N_DIFF_HEADS * 2 * HEAD_DIM
N_DIL_HEADS = 8
DIL_WIDTH = N_DIL_HEADS * HEAD_DIM
MIX_WIDTH = DIFF_WIDTH + DIL_WIDTH
IN_WIDTH = 3 * DIFF_WIDTH + 3 * DIL_WIDTH
DIL_PATTERNS = ((128, 1), (512, 4), (2048, 16))
ROPE_THETA = 10000.0
N_MEM = 256
N_CROSS_HEADS = 4
CROSS_HEAD_DIM = D_MODEL // N_CROSS_HEADS
D_FF = 2816
CONV_WIDTH = 3
Q_BLOCK = 128
DIL_Q_BLOCK = 64
RMS_EPS = 1e-6

kernel_name = "hybrid_diff_dilated_encoder"


def rmsnorm(x, g):
    xf = x.astype(jnp.float32)
    y = xf * lax.rsqrt(jnp.mean(xf * xf, axis=-1, keepdims=True) + RMS_EPS)
    return (y * g.astype(jnp.float32)).astype(x.dtype)


def rope_tables(seq, dim):
    inv = 1.0 / (ROPE_THETA ** (jnp.arange(0, dim, 2, dtype=jnp.float32) / dim))
    ang = jnp.arange(seq, dtype=jnp.float32)[:, None] * inv[None, :]
    return jnp.cos(ang), jnp.sin(ang)


def apply_rope(x, cos, sin):
    x1, x2 = jnp.split(x.astype(jnp.float32), 2, axis=-1)
    c = cos[:, None, :]
    s = sin[:, None, :]
    return jnp.concatenate([x1 * c - x2 * s, x2 * c + x1 * s], axis=-1).astype(x.dtype)


def diff_attention(q, k, v, lam, sub_g, lambda_init):
    B, S, H, _, d = q.shape
    nb = S // Q_BLOCK
    scale = d ** -0.5
    qb = q.reshape(B, nb, Q_BLOCK, H, 2, d).transpose(1, 0, 2, 3, 4, 5)

    def block(qblk):
        s = jnp.einsum('bqhcd,bkhcd->bhcqk', qblk, k).astype(jnp.float32) * scale
        p = jax.nn.softmax(s, axis=-1)
        w = p[:, :, 0] - lam * p[:, :, 1]
        return jnp.einsum('bhqk,bkhe->bqhe', w.astype(v.dtype), v)

    o = lax.map(block, qb)
    o = o.transpose(1, 0, 2, 3, 4).reshape(B, S, H, 2 * d)
    o = rmsnorm(o, sub_g) * (1.0 - lambda_init)
    return o.reshape(B, S, H * 2 * d)


def dilated_offsets():
    sizes = [2 * (w // (2 * r)) + 1 for (w, r) in DIL_PATTERNS]
    J = max(sizes)
    offs = np.zeros((len(DIL_PATTERNS), J), np.int32)
    valid = np.zeros((len(DIL_PATTERNS), J), bool)
    for g, (w, r) in enumerate(DIL_PATTERNS):
        n = w // (2 * r)
        o = r * np.arange(-n, n + 1)
        offs[g, :o.shape[0]] = o
        valid[g, :o.shape[0]] = True
    return offs, valid


def dilated_attention(q, k, v):
    B, S, H, d = q.shape
    offs_np, valid_np = dilated_offsets()
    reach = int(np.abs(offs_np).max())
    offs = jnp.asarray(offs_np)
    valid = jnp.asarray(valid_np)
    kp = jnp.pad(k, ((0, 0), (reach, reach), (0, 0), (0, 0)))
    vp = jnp.pad(v, ((0, 0), (reach, reach), (0, 0), (0, 0)))
    nb = S // DIL_Q_BLOCK
    scale = d ** -0.5
    qb = q.reshape(B, nb, DIL_Q_BLOCK, H, d).transpose(1, 0, 2, 3, 4)
    starts = jnp.arange(nb, dtype=jnp.int32) * DIL_Q_BLOCK

    def block(args):
        qblk, start = args
        pos = start + jnp.arange(DIL_Q_BLOCK, dtype=jnp.int32)
        kpos = pos[:, None, None] + offs[None]
        ok = valid[None] & (kpos >= 0) & (kpos < S)
        idx = kpos + reach
        kg = jnp.take(kp, idx, axis=1)
        vg = jnp.take(vp, idx, axis=1)
        s = jnp.einsum('bqhd,bqgjhd->bqghj', qblk, kg).astype(jnp.float32) * scale
        s = jnp.where(ok[None, :, :, None, :], s, -jnp.inf)
        lse = jax.nn.logsumexp(s, axis=-1)
        p = jnp.exp(s - lse[..., None])
        o = jnp.einsum('bqghj,bqgjhd->bqghd', p.astype(v.dtype), vg)
        alpha = jax.nn.softmax(lse, axis=2)
        return jnp.einsum('bqgh,bqghd->bqhd', alpha.astype(o.dtype), o)

    o = lax.map(block, (qb, starts))
    return o.transpose(1, 0, 2, 3, 4).reshape(B, S, H * d)


def memory_cross_attention(h, mem_n, w_q, w_kv, w_o):
    B, S, _ = h.shape
    M = mem_n.shape[1]
    q = (h @ w_q).reshape(B, S, N_CROSS_HEADS, CROSS_HEAD_DIM)
    kv = (mem_n @ w_kv).reshape(B, M, 2, N_CROSS_HEADS, CROSS_HEAD_DIM)
    k = kv[:, :, 0]
    v = kv[:, :, 1]
    s = jnp.einsum('bqhd,bmhd->bhqm', q, k).astype(jnp.float32) * (CROSS_HEAD_DIM ** -0.5)
    p = jax.nn.softmax(s, axis=-1)
    o = jnp.einsum('bhqm,bmhd->bqhd', p.astype(v.dtype), v).reshape(B, S, D_MODEL)
    return o @ w_o


def conv_gated_mlp(h, w_up, conv_w, conv_b, w_down):
    S = h.shape[1]
    u = h @ w_up
    half = CONV_WIDTH // 2
    up = jnp.pad(u, ((0, 0), (half, half), (0, 0)))
    c = conv_b
    for t in range(CONV_WIDTH):
        c = c + up[:, t:t + S] * conv_w[t]
    gate, val = jnp.split(c, 2, axis=-1)
    return (jax.nn.gelu(gate, approximate=True) * val) @ w_down


def encoder_trunk(x, mem, p):
    B, S, _ = x.shape
    cos, sin = rope_tables(S, HEAD_DIM)
    splits = np.cumsum([DIFF_WIDTH, DIFF_WIDTH, DIFF_WIDTH, DIL_WIDTH, DIL_WIDTH]).tolist()
    for l in range(DEPTH):
        lambda_init = 0.8 - 0.6 * math.exp(-0.3 * l)
        h = rmsnorm(x, p['mix_pre_g'][l])
        qa, ka, va, qd, kd, vd = jnp.split(h @ p['w_in'][l], splits, axis=-1)
        qa = apply_rope(qa.reshape(B, S, 2 * N_DIFF_HEADS, HEAD_DIM), cos, sin).reshape(B, S, N_DIFF_HEADS, 2, HEAD_DIM)
        ka = apply_rope(ka.reshape(B, S, 2 * N_DIFF_HEADS, HEAD_DIM), cos, sin).reshape(B, S, N_DIFF_HEADS, 2, HEAD_DIM)
        va = va.reshape(B, S, N_DIFF_HEADS, 2 * HEAD_DIM)
        lam = (jnp.exp(jnp.sum(p['lambda_q1'][l].astype(jnp.float32) * p['lambda_k1'][l].astype(jnp.float32)))
               - jnp.exp(jnp.sum(p['lambda_q2'][l].astype(jnp.float32) * p['lambda_k2'][l].astype(jnp.float32)))
               + lambda_init)
        oa = diff_attention(qa, ka, va, lam, p['diff_subln_g'][l], lambda_init)
        qd = apply_rope(qd.reshape(B, S, N_DIL_HEADS, HEAD_DIM), cos, sin)
        kd = apply_rope(kd.reshape(B, S, N_DIL_HEADS, HEAD_DIM), cos, sin)
        vd = vd.reshape(B, S, N_DIL_HEADS, HEAD_DIM)
        od = dilated_attention(qd, kd, vd)
        mix = jnp.concatenate([oa, od], axis=-1) @ p['w_out'][l]
        x = x + rmsnorm(mix, p['mix_post_g'][l])
        h = rmsnorm(x, p['xattn_pre_g'][l])
        mem_n = rmsnorm(mem, p['mem_norm_g'][l])
        c = memory_cross_attention(h, mem_n, p['w_xq'][l], p['w_xkv'][l], p['w_xo'][l])
        x = x + rmsnorm(c, p['xattn_post_g'][l])
        h = rmsnorm(x, p['ffn_pre_g'][l])
        f = conv_gated_mlp(h, p['w_up'][l], p['conv_w'][l], p['conv_b'][l], p['w_down'][l])
        x = x + rmsnorm(f, p['ffn_post_g'][l])
    return x


def setup_inputs(seed: int = 0) -> dict:
    key = jax.random.key(seed)
    ks = jax.random.split(key, 32)
    f32 = jnp.float32

    def nrm(k, shape, scale):
        return jax.random.normal(k, shape, f32) * scale

    def gain(k):
        return 1.0 + 0.1 * jax.random.normal(k, (DEPTH, D_MODEL), f32)

    return {
        'x_prompt': nrm(ks[0], (BATCH, SEQ, D_MODEL), 1.0),
        'x_sample': nrm(ks[1], (DEC_BATCH, DEC_SEQ, D_MODEL), 1.0),
        'mem_prompt': nrm(ks[2], (BATCH, N_MEM, D_MODEL), 1.0),
        'mem_sample': nrm(ks[3], (DEC_BATCH, N_MEM, D_MODEL), 1.0),
        'w_in': nrm(ks[4], (DEPTH, D_MODEL, IN_WIDTH), D_MODEL ** -0.5),
        'w_out': nrm(ks[5], (DEPTH, MIX_WIDTH, D_MODEL), MIX_WIDTH ** -0.5),
        'lambda_q1': nrm(ks[6], (DEPTH, HEAD_DIM), 0.1),
        'lambda_k1': nrm(ks[7], (DEPTH, HEAD_DIM), 0.1),
        'lambda_q2': nrm(ks[8], (DEPTH, HEAD_DIM), 0.1),
        'lambda_k2': nrm(ks[9], (DEPTH, HEAD_DIM), 0.1),
        'diff_subln_g': 1.0 + 0.1 * jax.random.normal(ks[10], (DEPTH, 2 * HEAD_DIM), f32),
        'w_xq': nrm(ks[11], (DEPTH, D_MODEL, D_MODEL), D_MODEL ** -0.5),
        'w_xkv': nrm(ks[12], (DEPTH, D_MODEL, 2 * D_MODEL), D_MODEL ** -0.5),
        'w_xo': nrm(ks[13], (DEPTH, D_MODEL, D_MODEL), D_MODEL ** -0.5),
        'w_up': nrm(ks[14], (DEPTH, D_MODEL, 2 * D_FF), D_MODEL ** -0.5),
        'conv_w': nrm(ks[15], (DEPTH, CONV_WIDTH, 2 * D_FF), CONV_WIDTH ** -0.5),
        'conv_b': nrm(ks[16], (DEPTH, 2 * D_FF), 0.01),
        'w_down': nrm(ks[17], (DEPTH, D_FF, D_MODEL), D_FF ** -0.5),
        'mix_pre_g': gain(ks[18]),
        'mix_post_g': gain(ks[19]),
        'mem_norm_g': gain(ks[20]),
        'xattn_pre_g': gain(ks[21]),
        'xattn_post_g': gain(ks[22]),
        'ffn_pre_g': gain(ks[23]),
        'ffn_post_g': gain(ks[24]),
    }


def reference(x_prompt, x_sample, mem_prompt, mem_sample, w_in, w_out, lambda_q1, lambda_k1,
              lambda_q2, lambda_k2, diff_subln_g, w_xq, w_xkv, w_xo, w_up, conv_w, conv_b, w_down,
              mix_pre_g, mix_post_g, mem_norm_g, xattn_pre_g, xattn_post_g, ffn_pre_g, ffn_post_g):
    params = {
        'w_in': w_in, 'w_out': w_out,
        'lambda_q1': lambda_q1, 'lambda_k1': lambda_k1,
        'lambda_q2': lambda_q2, 'lambda_k2': lambda_k2,
        'diff_subln_g': diff_subln_g,
        'w_xq': w_xq, 'w_xkv': w_xkv, 'w_xo': w_xo,
        'w_up': w_up, 'conv_w': conv_w, 'conv_b': conv_b, 'w_down': w_down,
        'mix_pre_g': mix_pre_g, 'mix_post_g': mix_post_g, 'mem_norm_g': mem_norm_g,
        'xattn_pre_g': xattn_pre_g, 'xattn_post_g': xattn_post_g,
        'ffn_pre_g': ffn_pre_g, 'ffn_post_g': ffn_post_g,
    }
    y_prompt = encoder_trunk(x_prompt, mem_prompt, params)
    y_sample = encoder_trunk(x_sample, mem_sample, params)
    return (y_prompt, y_sample)
```

```cpp
#include <hip/hip_runtime.h>
#include <hip/hip_cooperative_groups.h>
#include <cstdio>
#include <cstdint>
#include <cmath>
namespace cg = cooperative_groups;

#define LAS __attribute__((address_space(3)))
#define DI __device__ __forceinline__
#define GAS __attribute__((address_space(1)))
typedef unsigned short bf16_t;
typedef short bf16x8 __attribute__((ext_vector_type(8)));
typedef float f32x4 __attribute__((ext_vector_type(4)));
typedef float f32x2 __attribute__((ext_vector_type(2)));
typedef float f32x16 __attribute__((ext_vector_type(16)));
typedef unsigned u32x4 __attribute__((ext_vector_type(4)));
typedef unsigned u32x2 __attribute__((ext_vector_type(2)));
typedef __bf16 bf16x2_t __attribute__((ext_vector_type(2)));

constexpr int DM = 1024;
constexpr int NTOK = 49152, TOK_P = 16384, TOK_S = 32768;
constexpr int DFF = 2816, DFF2 = 5632;
constexpr float RMS_EPS = 1e-6f;
constexpr float LOG2E = 1.4426950408889634f;
constexpr size_t MiB = 1u << 20;
constexpr size_t WS_ROPE_C = 2 * MiB, WS_ROPE_S = 4 * MiB, WS_LSE = 6 * MiB;
constexpr size_t WS_W = 8 * MiB;
constexpr size_t W_QK = 0, W_V = 4 * MiB, W_O = 6 * MiB, W_XQ = 8 * MiB, W_XK = 10 * MiB, W_XV = 12 * MiB, W_XO = 14 * MiB, W_UP = 16 * MiB, W_DN = 27 * MiB,
                 W_MEMN = 33 * MiB, W_KMEM = 36 * MiB, W_VMEM = 39 * MiB, W_BT1 = 42 * MiB, W_BT2 = 54 * MiB;
constexpr size_t WS_ACT = 74 * MiB;
constexpr size_t WS_BIG = 170 * MiB;
constexpr size_t WS_END = 498 * MiB;
constexpr int LDS_BYTES = 147456;
constexpr int LDS_SCR = 131072;

struct Params {
    const float* in[25];
    float* out;
    unsigned char* ws;
    double inv_freq[32];
    float lambda_init[2];
    int pad[2];
};

DI unsigned pk2(float lo, float hi) { f32x2 v = {lo, hi}; bf16x2_t b = __builtin_convertvector(v, bf16x2_t); return __builtin_bit_cast(unsigned, b); }
DI float bf_lo(unsigned u) { return __uint_as_float(u << 16); }
DI float bf_hi(unsigned u) { return __uint_as_float(u & 0xffff0000u); }
DI float shx(float v, int o, int lane) { return __uint_as_float((unsigned)__builtin_amdgcn_ds_bpermute((lane ^ o) << 2, (int)__float_as_uint(v))); }
DI float wave_sum(float v, int lane) {
#pragma unroll
    for (int o = 1; o < 64; o <<= 1) v += shx(v, o, lane);
    return v;
}
DI float swap_max(float m) { auto rr = __builtin_amdgcn_permlane32_swap(__float_as_uint(m), __float_as_uint(m), false, false); return fmaxf(__uint_as_float(rr[0]), __uint_as_float(rr[1])); }
DI float swap_sum(float m) { auto rr = __builtin_amdgcn_permlane32_swap(__float_as_uint(m), __float_as_uint(m), false, false); return __uint_as_float(rr[0]) + __uint_as_float(rr[1]); }
DI float max3f(float a, float b, float c) { float r; asm("v_max3_f32 %0, %1, %2, %3" : "=v"(r) : "v"(a), "v"(b), "v"(c)); return r; }
DI float ex2(float x) { return __builtin_amdgcn_exp2f(x); }
DI int get_tid(int w) { unsigned z; asm volatile("s_mov_b32 %0, 0" : "=s"(z)); const int ln = __builtin_amdgcn_mbcnt_hi(~0u, __builtin_amdgcn_mbcnt_lo(~0u, z)); int t = w * 64 + ln; asm volatile("" : "+v"(t)); return t; }
DI void* ldptr(const LAS unsigned long long* t) { unsigned z; asm volatile("s_mov_b32 %0, 0" : "=s"(z)); const unsigned long long v = *(const LAS unsigned long long*)(size_t)((unsigned)(size_t)t + z); const unsigned lo = __builtin_amdgcn_readfirstlane((unsigned)v), hi = __builtin_amdgcn_readfirstlane((unsigned)(v >> 32)); return (void*)(((unsigned long long)hi << 32) | lo); }
#define MFMA32(a, b, c) __builtin_amdgcn_mfma_f32_32x32x16_bf16((a), (b), (c), 0, 0, 0)

namespace pg8 {
constexpr int BM = 256, BK = 64, HALF = 128, HTB = HALF * BK * 2, STAGE_BYTES = 8 * HTB, NXCD = 8, WGM = 8;
__host__ __device__ __forceinline__ int lds_byte(int r, int c) { const int st = (r >> 4) * 2 + (c >> 5), rr = r & 15, cc = c & 31, ob = rr * 64 + cc * 2; return st * 1024 + (ob ^ (((ob >> 9) & 1) << 5)); }
__host__ __device__ __forceinline__ void stage_rc(int b, int& R, int& C) { const int st = b / 1024, sb = b % 1024, swz = sb ^ (((sb >> 9) & 1) << 5); R = (st >> 1) * 16 + swz / 64; C = (st & 1) * 32 + (swz % 64) / 2; }
__host__ __device__ __forceinline__ int perm32(int rho) { const int n = rho >> 4, i = rho & 15; return 8 * (i >> 2) + 4 * n + (i & 3); }

struct Unit { int pm, pn; };

struct Sched {
    const bf16_t* A; const bf16_t* B; int lda, ldb, K; int nM, nN, nwg, G, c; int mode, p0, p1;
    DI void init(const bf16_t* A_, int lda_, int nM_, const bf16_t* B_, int ldb_, int nN_, int K_, int mode_ = 0, int p0_ = 0, int p1_ = 0, int coff = 0) {
        A = A_; B = B_; lda = lda_; ldb = ldb_; K = K_; nM = nM_; nN = nN_; nwg = nM * nN; G = gridDim.x; c = (int)((blockIdx.x + (unsigned)coff) % gridDim.x); mode = mode_; p0 = p0_; p1 = p1_;
    }
    DI bool next(int i, Unit& u) const {
        const long L = (long)i * G + c; if (L >= nwg) return false;
        int wgid = (int)L; { const int q = nwg / NXCD, r = nwg % NXCD, xcd = wgid % NXCD, off = wgid / NXCD; wgid = (xcd < r ? xcd * (q + 1) : r * (q + 1) + (xcd - r) * q) + off; }
        const int nig = WGM * nN, gid = wgid / nig, fm = gid * WGM, gsz = (nM - fm) < WGM ? (nM - fm) : WGM;
        u.pm = fm + ((wgid % nig) % gsz); u.pn = (wgid % nig) / gsz; return true;
    }
    DI const char* baseA(const Unit& u) const {
        if (mode == 3) return (const char*)(A + (size_t)(u.pm >> 2) * 256 * 1024 + (u.pm & 3) * 256);
        if (mode == 4) return (const char*)(A + (size_t)u.pm * 256 * 1024 + (u.pn & 3) * 256);
        if (mode == 5) return (const char*)(A + ((long)254 * u.pm - 1) * lda);
        return (const char*)(A + (size_t)u.pm * 256 * lda);
    }
    DI const char* baseB(const Unit& u) const {
        if (mode == 1) { const int S = p0, rr = p1, Sr = S >> __builtin_ctz(rr); const int pos = u.pn * 256, seq = pos >> __builtin_ctz(S), within = pos & (S - 1), cls = within >> __builtin_ctz(Sr), m0 = within & (Sr - 1);
            return (const char*)(B + ((size_t)seq * S + (size_t)m0 * rr + cls) * 1024); }
        if (mode == 2) { const int b = u.pm < 64 ? (u.pm >> 4) : 4 + ((u.pm - 64) >> 6); return (const char*)(B + (size_t)b * 1048576 + (size_t)u.pn * 256 * 1024); }
        if (mode == 3) return (const char*)(B + (size_t)u.pn * 256 * 1024 + (u.pm & 3) * 256);
        if (mode == 4) return (const char*)(B + (size_t)(u.pn >> 2) * 256 * 1024 + (u.pn & 3) * 256);
        return (const char*)(B + (size_t)u.pn * 256 * ldb);
    }
};

typedef f32x4 Acc[2][2][4][2];

struct EpiBf16 {
    static constexpr bool PERM = true;
    bf16_t* O; long ldc; long pm_stride; int pnmode; float scale;
    DI void operator()(const Acc& acc, const Unit& u, int wr, int wc, int fr, int fq, LAS unsigned char*) const {
        const long pnoff = pnmode == 1 ? (long)(u.pn >> 2) * 1048576 + (u.pn & 3) * 256 : (long)u.pn * 256;
        bf16_t* base = O + (long)u.pm * pm_stride + pnoff + (long)(wr * 64 + fr) * ldc + wc * 32 + 8 * fq;
#pragma unroll
        for (int ai = 0; ai < 2; ++ai)
#pragma unroll
            for (int m = 0; m < 4; ++m) { bf16_t* rowp = base + (long)(ai * HALF + m * 16) * ldc;
#pragma unroll
                for (int bj = 0; bj < 2; ++bj) { const f32x4 v0 = acc[ai][bj][m][0] * scale, v1 = acc[ai][bj][m][1] * scale;
                    u32x4 w; w.x = pk2(v0[0], v0[1]); w.y = pk2(v0[2], v0[3]); w.z = pk2(v1[0], v1[1]); w.w = pk2(v1[2], v1[3]);
                    *(GAS u32x4*)(rowp + bj * HALF) = w; } }
    }
};
struct EpiVtd {
    static constexpr bool PERM = true;
    bf16_t* O; long rows;
    DI void operator()(const Acc& acc, const Unit& u, int wr, int wc, int fr, int fq, LAS unsigned char*) const {
        bf16_t* base = O + (long)(u.pm * 4 + wr) * rows * 64 + fr * 8 + (long)(u.pn * 32 + wc * 4 + fq) * 512;
#pragma unroll
        for (int ai = 0; ai < 2; ++ai)
#pragma unroll
            for (int m = 0; m < 4; ++m) { bf16_t* rowp = base + (long)ai * 2 * rows * 64 + m * 128;
#pragma unroll
                for (int bj = 0; bj < 2; ++bj) { const f32x4 v0 = acc[ai][bj][m][0], v1 = acc[ai][bj][m][1];
                    u32x4 w; w.x = pk2(v0[0], v0[1]); w.y = pk2(v0[2], v0[3]); w.z = pk2(v1[0], v1[1]); w.w = pk2(v1[2], v1[3]);
                    *(GAS u32x4*)(rowp + bj * 16 * 512) = w; } }
    }
};
DI float dpp_ror1(float x) { return __builtin_bit_cast(float, __builtin_amdgcn_update_dpp(0, __builtin_bit_cast(int, x), 0x121, 0xf, 0xf, false)); }
DI float dpp_rol1(float x) { return __builtin_bit_cast(float, __builtin_amdgcn_update_dpp(0, __builtin_bit_cast(int, x), 0x12F, 0xf, 0xf, false)); }
DI f32x4 ror4(f32x4 v) { return (f32x4){dpp_ror1(v[0]), dpp_ror1(v[1]), dpp_ror1(v[2]), dpp_ror1(v[3])}; }
DI f32x4 rol4(f32x4 v) { return (f32x4){dpp_rol1(v[0]), dpp_rol1(v[1]), dpp_rol1(v[2]), dpp_rol1(v[3])}; }
DI float gelu_t(float x) { const float y = 0.7978845608028654f * (x + 0.044715f * x * x * x); const float e = ex2(2.8853900817779268f * y);
    return x - x * __builtin_amdgcn_rcpf(1.0f + e); }
struct EpiConvGate {
    static constexpr bool PERM = true;
    bf16_t* G; const float* cw; const float* cb; int smask; int chunk_rows;
    DI f32x4 conv1(const Acc& acc, int ai, int bj, int n, int m, int fr, const f32x4& above, const f32x4& below, const f32x4& w0, const f32x4& w1, const f32x4& w2, const f32x4& b, bool zp, bool zn) const {
        const f32x4 cur = acc[ai][bj][m][n];
        const f32x4 tp = (m > 0 && fr == 15) ? acc[ai][bj][m > 0 ? m - 1 : 0][n] : cur;
        const f32x4 tn = (m < 3 && fr == 0) ? acc[ai][bj][m < 3 ? m + 1 : 3][n] : cur;
        f32x4 pv = ror4(tp), nx = rol4(tn);
        if (m == 0 && fr == 0) pv = above;
        if (m == 3 && fr == 15) nx = below;
        if (zp) pv = (f32x4){0.f, 0.f, 0.f, 0.f};
        if (zn) nx = (f32x4){0.f, 0.f, 0.f, 0.f};
        return b + w0 * pv + w1 * cur + w2 * nx;
    }
    DI void operator()(const Acc& acc, const Unit& u, int wr, int wc, int fr, int fq, LAS unsigned char* scr) const {
        LAS float* H = (LAS float*)scr;
        const int colb = wc * 32 + 8 * fq;
        if (fr == 0 || fr == 15) {
#pragma unroll
            for (int ai = 0; ai < 2; ++ai)
#pragma unroll
                for (int bj = 0; bj < 2; ++bj)
#pragma unroll
                    for (int n = 0; n < 2; ++n) {
                        LAS f32x4* dst = (LAS f32x4*)(H + (((2 * ai + wr) * 2 + (fr == 0 ? 0 : 1)) * 256 + bj * HALF + colb + 4 * n));
                        *dst = (fr == 0) ? acc[ai][bj][0][n] : acc[ai][bj][3][n];
                    }
        }
        asm volatile("s_waitcnt lgkmcnt(0)" ::: "memory"); __builtin_amdgcn_s_barrier(); asm volatile("" ::: "memory");
        const int f0 = u.pn * 128 + colb;
        const int row_base = 254 * u.pm - 1;
#pragma unroll
        for (int ai = 0; ai < 2; ++ai) {
            const int k = 2 * ai + wr, ka = k > 0 ? k - 1 : 0, kb = k < 3 ? k + 1 : 3;
#pragma unroll
            for (int n = 0; n < 2; ++n) {
                const float* wp = cw + f0 + 4 * n;
                const f32x4 g0 = *(const f32x4*)wp, g1 = *(const GAS f32x4*)(wp + DFF2), g2 = *(const GAS f32x4*)(wp + 2 * DFF2), gb = *(const GAS f32x4*)(cb + f0 + 4 * n);
                const f32x4 v0 = *(const GAS f32x4*)(wp + DFF), v1 = *(const GAS f32x4*)(wp + DFF + DFF2), v2 = *(const GAS f32x4*)(wp + DFF + 2 * DFF2), vb = *(const GAS f32x4*)(cb + DFF + f0 + 4 * n);
                const f32x4 ag = *(const LAS f32x4*)(H + ((ka * 2 + 1) * 256 + colb + 4 * n)), bg = *(const LAS f32x4*)(H + ((kb * 2 + 0) * 256 + colb + 4 * n));
                const f32x4 av = *(const LAS f32x4*)(H + ((ka * 2 + 1) * 256 + HALF + colb + 4 * n)), bv = *(const LAS f32x4*)(H + ((kb * 2 + 0) * 256 + HALF + colb + 4 * n));
#pragma unroll
                for (int m = 0; m < 4; ++m) {
                    const int tr = ai * HALF + wr * 64 + m * 16 + fr, grow = row_base + tr;
                    const int sm = smask >= 0 ? smask : (grow < TOK_P ? 4095 : 16383);
                    const bool zp = (grow & sm) == 0, zn = ((grow + 1) & sm) == 0;
                    const f32x4 cg = conv1(acc, ai, 0, n, m, fr, ag, bg, g0, g1, g2, gb, zp, zn);
                    const f32x4 cv = conv1(acc, ai, 1, n, m, fr, av, bv, v0, v1, v2, vb, zp, zn);
                    if (tr >= 1 && tr <= 254 && grow >= 0 && grow < chunk_rows) {
                        u32x2 w; w.x = pk2(gelu_t(cg[0]) * cv[0], gelu_t(cg[1]) * cv[1]); w.y = pk2(gelu_t(cg[2]) * cv[2], gelu_t(cg[3]) * cv[3]);
                        *(GAS u32x2*)(G + (size_t)grow * DFF + f0 + 4 * n) = w;
                    }
                }
            }
        }
    }
};
struct EpiF32 {
    static constexpr bool PERM = false;
    float* O; long ldc;
    DI void operator()(const Acc& acc, const Unit& u, int wr, int wc, int fr, int fq, LAS unsigned char*) const {
        float* base = O + ((long)u.pm * 256 + wr * 64 + fr) * ldc + (long)u.pn * 256 + wc * 32 + 4 * fq;
#pragma unroll
        for (int ai = 0; ai < 2; ++ai)
#pragma unroll
            for (int m = 0; m < 4; ++m) { float* rowp = base + (long)(ai * HALF + m * 16) * ldc;
#pragma unroll
                for (int bj = 0; bj < 2; ++bj)
#pragma unroll
                    for (int n = 0; n < 2; ++n) *(GAS f32x4*)(rowp + bj * HALF + n * 16) = acc[ai][bj][m][n]; }
    }
};
struct EpiRope {
    static constexpr bool PERM = true;
    bf16_t* O; const float* cosT; const float* sinT; int smask; float qscale;
    DI void operator()(const Acc& acc, const Unit& u, int wr, int wc, int fr, int fq, LAS unsigned char*) const {
        const int sec = u.pn >> 1; const float sc = (sec == 0 || sec == 2) ? qscale : 1.0f;
#pragma unroll
        for (int ai = 0; ai < 2; ++ai)
#pragma unroll
            for (int m = 0; m < 4; ++m) {
                const int row = u.pm * 256 + ai * HALF + wr * 64 + m * 16 + fr, pos = row & smask;
                const f32x4 c0 = *(const GAS f32x4*)(cosT + pos * 32 + 8 * fq), c1 = *(const GAS f32x4*)(cosT + pos * 32 + 8 * fq + 4);
                const f32x4 s0 = *(const GAS f32x4*)(sinT + pos * 32 + 8 * fq), s1 = *(const GAS f32x4*)(sinT + pos * 32 + 8 * fq + 4);
                const f32x4 x10 = acc[ai][0][m][0], x11 = acc[ai][0][m][1], x20 = acc[ai][1][m][0], x21 = acc[ai][1][m][1];
                const f32x4 a0 = (x10 * c0 - x20 * s0) * sc, a1 = (x11 * c1 - x21 * s1) * sc, b0 = (x20 * c0 + x10 * s0) * sc, b1 = (x21 * c1 + x11 * s1) * sc;
                bf16_t* rowp = O + (long)row * 2048 + u.pn * 256 + wc * 64 + 8 * fq;
                u32x4 w; w.x = pk2(a0[0], a0[1]); w.y = pk2(a0[2], a0[3]); w.z = pk2(a1[0], a1[1]); w.w = pk2(a1[2], a1[3]); *(u32x4*)rowp = w;
                u32x4 v; v.x = pk2(b0[0], b0[1]); v.y = pk2(b0[2], b0[3]); v.z = pk2(b1[0], b1[1]); v.w = pk2(b1[2], b1[3]); *(GAS u32x4*)(rowp + 32) = v;
            }
    }
};
struct EpiSoftmax {
    static constexpr bool PERM = true;
    bf16_t* O; long ldc;
    DI void operator()(Acc& acc, const Unit& u, int wr, int wc, int fr, int fq, LAS unsigned char* scr) const {
        LAS float* red = (LAS float*)scr;
#pragma unroll
        for (int ai = 0; ai < 2; ++ai)
#pragma unroll
            for (int m = 0; m < 4; ++m) { float a = -3.0e38f;
#pragma unroll
                for (int bj = 0; bj < 2; ++bj)
#pragma unroll
                    for (int n = 0; n < 2; ++n) { const f32x4 x = acc[ai][bj][m][n]; a = fmaxf(a, fmaxf(fmaxf(x[0], x[1]), fmaxf(x[2], x[3]))); }
                a = fmaxf(a, shx(a, 16, fq * 16 + fr)); a = fmaxf(a, shx(a, 32, fq * 16 + fr));
                if (fq == 0) red[(ai * HALF + wr * 64 + m * 16 + fr) * 4 + wc] = a; }
        asm volatile("s_waitcnt lgkmcnt(0)" ::: "memory"); __builtin_amdgcn_s_barrier(); asm volatile("" ::: "memory");
#pragma unroll
        for (int ai = 0; ai < 2; ++ai)
#pragma unroll
            for (int m = 0; m < 4; ++m) { const f32x4 t = *(const LAS f32x4*)(red + (ai * HALF + wr * 64 + m * 16 + fr) * 4);
                const float M = fmaxf(fmaxf(t[0], t[1]), fmaxf(t[2], t[3])); float s = 0.f;
#pragma unroll
                for (int bj = 0; bj < 2; ++bj)
#pragma unroll
                    for (int n = 0; n < 2; ++n) { f32x4 x = acc[ai][bj][m][n]; x[0] = ex2(x[0] - M); x[1] = ex2(x[1] - M); x[2] = ex2(x[2] - M); x[3] = ex2(x[3] - M); acc[ai][bj][m][n] = x; s += (x[0] + x[1]) + (x[2] + x[3]); }
                s += shx(s, 16, fq * 16 + fr); s += shx(s, 32, fq * 16 + fr);
                if (fq == 0) red[1024 + (ai * HALF + wr * 64 + m * 16 + fr) * 4 + wc] = s; }
        asm volatile("s_waitcnt lgkmcnt(0)" ::: "memory"); __builtin_amdgcn_s_barrier(); asm volatile("" ::: "memory");
        bf16_t* base = O + ((long)u.pm * 256 + wr * 64 + fr) * ldc + (long)u.pn * 256 + wc * 32 + 8 * fq;
#pragma unroll
        for (int ai = 0; ai < 2; ++ai)
#pragma unroll
            for (int m = 0; m < 4; ++m) { const f32x4 t = *(const LAS f32x4*)(red + 1024 + (ai * HALF + wr * 64 + m * 16 + fr) * 4);
                const float inv = __builtin_amdgcn_rcpf((t[0] + t[1]) + (t[2] + t[3])); bf16_t* rowp = base + (long)(ai * HALF + m * 16) * ldc;
#pragma unroll
                for (int bj = 0; bj < 2; ++bj) { const f32x4 v0 = acc[ai][bj][m][0] * inv, v1 = acc[ai][bj][m][1] * inv;
                    u32x4 w; w.x = pk2(v0[0], v0[1]); w.y = pk2(v0[2], v0[3]); w.z = pk2(v1[0], v1[1]); w.w = pk2(v1[2], v1[3]);
                    *(GAS u32x4*)(rowp + bj * HALF) = w; } }
        asm volatile("s_waitcnt lgkmcnt(0)" ::: "memory");
    }
};

template <class Epi>
DI void gemm_phase(int wv, LAS unsigned char* lds, LAS unsigned char* scr, const Sched& S, const Epi& E) {
    const int tid = get_tid(wv);
    const int wid = __builtin_amdgcn_readfirstlane(tid >> 6), lane = tid & 63, wr = wid >> 2, wc = wid & 3, fr = lane & 15, fq = lane >> 4;
    const int K = S.K, nt = K / BK;
    unsigned voffA[2], voffB[2];
#pragma unroll
    for (int i = 0; i < 2; ++i) { int R, C; stage_rc(tid * 16 + i * 8192, R, C); const int Rb = Epi::PERM ? ((R & ~31) + perm32(R & 31)) : R;
        voffA[i] = (unsigned)(R * S.lda + C) * 2u; voffB[i] = (unsigned)(Rb * S.ldb + C) * 2u; }
    const size_t kstep = (size_t)(BK * 2);
    const size_t hstepA = (size_t)HALF * S.lda * 2, hstepB = (size_t)HALF * S.ldb * 2;
    const unsigned ldsw = (unsigned)wid * 1024u;
    const int aoff = lds_byte(wr * 64 + fr, fq * 8), boff = lds_byte(wc * 32 + fr, fq * 8);
#define PG8_SA(b, h) (((b) * 2 + (h)) * HTB)
#define PG8_SB(b, h) ((4 + (b) * 2 + (h)) * HTB)
#define PG8_STAGE(bufoff, gbase, voff) do { _Pragma("unroll") for (int _i = 0; _i < 2; ++_i) \
        __builtin_amdgcn_global_load_lds((const unsigned*)((const char*)(gbase) + (voff)[_i]), (LAS unsigned*)(lds + (bufoff) + ldsw + _i * 8192), 16, 0, 0); } while (0)
#define PG8_LDA(dst, b, h) do { _Pragma("unroll") for (int m = 0; m < 4; ++m) _Pragma("unroll") for (int k = 0; k < 2; ++k) dst[m][k] = *(const LAS bf16x8*)(lds + PG8_SA(b, h) + aoff + m * 2048 + k * 1024); } while (0)
#define PG8_LDB(dst, b, h) do { _Pragma("unroll") for (int n = 0; n < 2; ++n) _Pragma("unroll") for (int k = 0; k < 2; ++k) dst[n][k] = *(const LAS bf16x8*)(lds + PG8_SB(b, h) + boff + n * 2048 + k * 1024); } while (0)
#define PG8_MMA(ai, bj, At, Bt) do { __builtin_amdgcn_s_setprio(1); _Pragma("unroll") for (int m = 0; m < 4; ++m) _Pragma("unroll") for (int n = 0; n < 2; ++n) _Pragma("unroll") for (int k = 0; k < 2; ++k) \
        acc[ai][bj][m][n] = __builtin_amdgcn_mfma_f32_16x16x32_bf16(Bt[n][k], At[m][k], acc[ai][bj][m][n], 0, 0, 0); __builtin_amdgcn_s_setprio(0); } while (0)
#define PG8_WAIT_V(n) asm volatile("s_waitcnt vmcnt(" #n ")" ::: "memory")
#define PG8_WAIT_L(n) asm volatile("s_waitcnt lgkmcnt(" #n ")" ::: "memory")
#define PG8_BAR __builtin_amdgcn_s_barrier()
#define PG8_SCHED __builtin_amdgcn_sched_barrier(0)
    Unit cur, nxt; int ui = 0;
    if (!S.next(0, cur)) return;
    Acc acc;
#pragma unroll
    for (int a = 0; a < 2; ++a)
#pragma unroll
        for (int b = 0; b < 2; ++b)
#pragma unroll
            for (int m = 0; m < 4; ++m)
#pragma unroll
                for (int n = 0; n < 2; ++n) acc[a][b][m][n] = (f32x4){0.f, 0.f, 0.f, 0.f};
    bf16x8 At[4][2], B0[2][2], B1[2][2];
    const char* cA = S.baseA(cur); const char* cB = S.baseB(cur);
    PG8_STAGE(PG8_SB(0, 0), cB, voffB); PG8_STAGE(PG8_SB(0, 1), cB + hstepB, voffB); PG8_STAGE(PG8_SA(0, 0), cA, voffA); PG8_STAGE(PG8_SA(0, 1), cA + hstepA, voffA);
    if (wr == 1) PG8_BAR;
    PG8_WAIT_V(2); PG8_BAR;
    PG8_STAGE(PG8_SB(1, 0), cB + kstep, voffB); PG8_STAGE(PG8_SA(1, 0), cA + kstep, voffA); PG8_STAGE(PG8_SB(1, 1), cB + hstepB + kstep, voffB);
    PG8_WAIT_V(6); PG8_BAR;
    for (;;) {
        const bool has_next = S.next(ui + 1, nxt);
        const char* nA = has_next ? S.baseA(nxt) : cA; const char* nB = has_next ? S.baseB(nxt) : cB;
        for (int t = 0; t < nt; t += 2) {
            const bool last = (t == nt - 2);
            const char* a1 = cA + (size_t)(t + 1) * kstep;
            const char* a2 = last ? nA : cA + (size_t)(t + 2) * kstep; const char* b2 = last ? nB : cB + (size_t)(t + 2) * kstep;
            const char* a3 = a2 + kstep; const char* b3 = b2 + kstep;
            PG8_LDB(B0, 0, 0); PG8_LDB(B1, 0, 1); PG8_SCHED; PG8_LDA(At, 0, 0); PG8_STAGE(PG8_SA(1, 1), a1 + hstepA, voffA);
            PG8_WAIT_V(8); PG8_WAIT_L(0); PG8_BAR; PG8_MMA(0, 0, At, B0); PG8_MMA(0, 1, At, B1); PG8_BAR; PG8_SCHED;
            PG8_LDA(At, 0, 1); PG8_STAGE(PG8_SB(0, 0), b2, voffB); PG8_STAGE(PG8_SB(0, 1), b2 + hstepB, voffB); PG8_STAGE(PG8_SA(0, 0), a2, voffA);
            PG8_WAIT_V(8); PG8_WAIT_L(0); PG8_BAR; PG8_MMA(1, 0, At, B0); PG8_MMA(1, 1, At, B1); PG8_BAR; PG8_SCHED;
            PG8_LDB(B0, 1, 0); PG8_LDB(B1, 1, 1); PG8_SCHED; PG8_LDA(At, 1, 0); PG8_STAGE(PG8_SA(0, 1), a2 + hstepA, voffA);
            PG8_WAIT_V(8); PG8_WAIT_L(0); PG8_BAR; PG8_MMA(0, 0, At, B0); PG8_MMA(0, 1, At, B1); PG8_BAR; PG8_SCHED;
            PG8_LDA(At, 1, 1); PG8_STAGE(PG8_SB(1, 0), b3, voffB); PG8_STAGE(PG8_SB(1, 1), b3 + hstepB, voffB); PG8_STAGE(PG8_SA(1, 0), a3, voffA);
            PG8_WAIT_V(8); PG8_WAIT_L(0); PG8_BAR; PG8_MMA(1, 0, At, B0); PG8_MMA(1, 1, At, B1); PG8_BAR; PG8_SCHED;
        }
        if (wr == 0) PG8_BAR;
        E(acc, cur, wr, wc, fr, fq, scr);
        if (!has_next) break;
#pragma unroll
        for (int a = 0; a < 2; ++a)
#pragma unroll
            for (int b = 0; b < 2; ++b)
#pragma unroll
                for (int m = 0; m < 4; ++m)
#pragma unroll
                    for (int n = 0; n < 2; ++n) acc[a][b][m][n] = (f32x4){0.f, 0.f, 0.f, 0.f};
        cur = nxt; cA = nA; cB = nB; ++ui;
        if (wr == 1) PG8_BAR;
    }
    PG8_WAIT_V(0);
    PG8_BAR;
#undef PG8_SA
#undef PG8_SB
#undef PG8_STAGE
#undef PG8_LDA
#undef PG8_LDB
#undef PG8_MMA
#undef PG8_WAIT_V
#undef PG8_WAIT_L
#undef PG8_BAR
#undef PG8_SCHED
}
}

template <class DR>
DI void transpose_item(const float* W, int ldw, int kb, int n0, bf16_t* WT, int Kd, LAS float* scr, int lane, const DR& drow) {
    const int k0 = 64 * kb;
#pragma unroll 8
    for (int i = 0; i < 32; ++i) { const int kk = 2 * i + (lane >> 5); scr[kk * 33 + (lane & 31)] = ((const GAS float*)W)[(size_t)(k0 + kk) * ldw + n0 + (lane & 31)]; }
    asm volatile("s_waitcnt lgkmcnt(0)" ::: "memory");
    const int c = lane & 7;
#pragma unroll
    for (int j = 0; j < 4; ++j) { const int n = (lane >> 3) + 8 * j; const LAS float* s = scr + (8 * c) * 33 + n;
        u32x4 o; o.x = pk2(s[0 * 33], s[1 * 33]); o.y = pk2(s[2 * 33], s[3 * 33]); o.z = pk2(s[4 * 33], s[5 * 33]); o.w = pk2(s[6 * 33], s[7 * 33]);
        *(GAS u32x4*)(WT + (size_t)drow(n0 + n) * Kd + k0 + 8 * c) = o; }
    asm volatile("s_waitcnt lgkmcnt(0)" ::: "memory");
}
struct DrowId { int off; DI int operator()(int n) const { return n + off; } };
struct DrowUp { DI int operator()(int s) const { const int isv = s >= DFF ? 1 : 0, f = s - isv * DFF; return (f >> 7) * 256 + isv * 128 + (f & 127); } };
struct DrowWin { DI int operator()(int s) const {
    const int sec = s >> 9, within = s & 511;
    if (sec == 2) return 2048 + within;
    if (sec == 5) return 2048 + 512 + within;
    const int dsec = sec < 2 ? sec : sec - 1; const int lc = dsec * 512 + within;
    return (lc & ~255) + ((lc >> 6) & 3) * 32 + (lc & 31) + 128 * ((lc >> 5) & 1); } };

DI void norm_row_bf16(const f32x4 (&v)[4], const float* g, bf16_t* orow, int lane) {
    float s = 0.f;
#pragma unroll
    for (int j = 0; j < 4; ++j) s += (v[j].x * v[j].x + v[j].y * v[j].y) + (v[j].z * v[j].z + v[j].w * v[j].w);
    const float rstd = __builtin_amdgcn_rsqf(wave_sum(s, lane) * (1.0f / DM) + RMS_EPS);
    GAS u32x2* o8 = (GAS u32x2*)orow + lane;
#pragma unroll
    for (int j = 0; j < 4; ++j) { const f32x4 gg = ((const GAS f32x4*)g)[lane + 64 * j]; u32x2 w; w.x = pk2(v[j].x * rstd * gg.x, v[j].y * rstd * gg.y); w.y = pk2(v[j].z * rstd * gg.z, v[j].w * rstd * gg.w); o8[64 * j] = w; }
}

DI void post_pass(int wv, const bf16_t* raw, long raw_row0, float* x, const float* gpost, const float* gpre, bf16_t* XN, int row_lo, int row_hi, const float* xin_p = nullptr, const float* xin_s = nullptr) {
    const int tid = get_tid(wv);
    const int lane = tid & 63, gw = blockIdx.x * 8 + __builtin_amdgcn_readfirstlane(tid >> 6), NGW = gridDim.x * 8;
    for (int row = row_lo + gw; row < row_hi; row += 2 * NGW) {
        f32x4 v[2][4], xv[2][4]; float s[2] = {0.f, 0.f};
#pragma unroll
        for (int q = 0; q < 2; ++q) { const int rw = row + q * NGW;
            const GAS u32x2* rr = (const GAS u32x2*)(raw + (size_t)(rw - raw_row0) * DM) + lane;
            const GAS f32x4* xr = (const GAS f32x4*)(xin_p ? (rw < TOK_P ? xin_p + (size_t)rw * DM : xin_s + (size_t)(rw - TOK_P) * DM) : x + (size_t)rw * DM) + lane;
#pragma unroll
            for (int j = 0; j < 4; ++j) { const u32x2 w = rr[64 * j]; v[q][j] = (f32x4){bf_lo(w.x), bf_hi(w.x), bf_lo(w.y), bf_hi(w.y)}; xv[q][j] = xr[64 * j]; } }
#pragma unroll
        for (int q = 0; q < 2; ++q)
#pragma unroll
            for (int j = 0; j < 4; ++j) s[q] += (v[q][j].x * v[q][j].x + v[q][j].y * v[q][j].y) + (v[q][j].z * v[q][j].z + v[q][j].w * v[q][j].w);
#pragma unroll
        for (int q = 0; q < 2; ++q) { const int rw = row + q * NGW; GAS f32x4* xr = (GAS f32x4*)(x + (size_t)rw * DM) + lane;
            const float rstd = __builtin_amdgcn_rsqf(wave_sum(s[q], lane) * (1.0f / DM) + RMS_EPS);
#pragma unroll
            for (int j = 0; j < 4; ++j) { const f32x4 gg = ((const GAS f32x4*)gpost)[lane + 64 * j]; xv[q][j] = xv[q][j] + v[q][j] * rstd * gg; xr[64 * j] = xv[q][j]; }
            if (gpre) norm_row_bf16(xv[q], gpre, XN + (size_t)rw * DM, lane); }
    }
}

DI float gelu_tanh(float x) { const float y = 0.7978845608028654f * (x + 0.044715f * x * x * x); const float e = __expf(2.0f * y); const float t = 1.0f - 2.0f / (1.0f + e); return 0.5f * x * (1.0f + t); }

DI void convgate_pass(int wv, const bf16_t* U, bf16_t* Gt, int rows, int smask, const float* cw, const float* cb) {
    const int tid = get_tid(wv);
    const long nitems = (long)(rows / 16) * 352; const long gt = (long)blockIdx.x * 512 + tid, ngt = (long)gridDim.x * 512;
    for (long it = gt; it < nitems; it += ngt) {
        const int cg8 = (int)(it % 352), rb = (int)(it / 352), j0 = cg8 * 8, r0 = rb * 16;
        float wg[3][8], wv[3][8], bg[8], bv[8];
#pragma unroll
        for (int t = 0; t < 3; ++t)
#pragma unroll
            for (int i = 0; i < 8; ++i) { wg[t][i] = cw[t * DFF2 + j0 + i]; wv[t][i] = cw[t * DFF2 + DFF + j0 + i]; }
#pragma unroll
        for (int i = 0; i < 8; ++i) { bg[i] = cb[j0 + i]; bv[i] = cb[DFF + j0 + i]; }
        const u32x4 zero = {0u, 0u, 0u, 0u};
        u32x4 gp, gc, gn, vp, vc, vn;
        const bf16_t* base = U + (size_t)r0 * DFF2 + j0;
        if ((r0 & smask) == 0) { gp = zero; vp = zero; } else { gp = *(const GAS u32x4*)(base - DFF2); vp = *(const GAS u32x4*)(base - DFF2 + DFF); }
        gc = *(const u32x4*)base; vc = *(const GAS u32x4*)(base + DFF);
#pragma unroll
        for (int r = 0; r < 16; ++r) {
            const int row = r0 + r;
            if (((row + 1) & smask) == 0) { gn = zero; vn = zero; } else { gn = *(const GAS u32x4*)(base + (size_t)(r + 1) * DFF2); vn = *(const GAS u32x4*)(base + (size_t)(r + 1) * DFF2 + DFF); }
            u32x4 o;
#pragma unroll
            for (int q = 0; q < 4; ++q) {
                const float g0 = bg[2 * q] + bf_lo(gp[q]) * wg[0][2 * q] + bf_lo(gc[q]) * wg[1][2 * q] + bf_lo(gn[q]) * wg[2][2 * q];
                const float g1 = bg[2 * q + 1] + bf_hi(gp[q]) * wg[0][2 * q + 1] + bf_hi(gc[q]) * wg[1][2 * q + 1] + bf_hi(gn[q]) * wg[2][2 * q + 1];
                const float v0 = bv[2 * q] + bf_lo(vp[q]) * wv[0][2 * q] + bf_lo(vc[q]) * wv[1][2 * q] + bf_lo(vn[q]) * wv[2][2 * q];
                const float v1 = bv[2 * q + 1] + bf_hi(vp[q]) * wv[0][2 * q + 1] + bf_hi(vc[q]) * wv[1][2 * q + 1] + bf_hi(vn[q]) * wv[2][2 * q + 1];
                o[q] = pk2(gelu_tanh(g0) * v0, gelu_tanh(g1) * v1);
            }
            *(GAS u32x4*)(Gt + (size_t)row * DFF + j0) = o;
            gp = gc; gc = gn; vp = vc; vc = vn;
        }
    }
}

#define GLDS16(gp, ldst) __builtin_amdgcn_global_load_lds((const unsigned*)(gp), (LAS unsigned*)(ldst), 16, 0, 0)
DI void glds16_s(const void* sbase, unsigned voff, unsigned ldsaddr) {
    unsigned keep;
    asm volatile("s_mov_b32 %0, m0\n\ts_mov_b32 m0, %3\n\ts_nop 0\n\tglobal_load_lds_dwordx4 %1, %2\n\ts_mov_b32 m0, %0" : "=&s"(keep) : "v"(voff), "s"(sbase), "s"(ldsaddr) : "memory");
}
DI void attn_step32(f32x16& sc, f32x16& sn, f32x16 (&O)[4], const f32x16& negm, float& lsum, float& mrun, const bf16x8 (&qf)[4],
                    bf16x8 (&kf)[4], const LAS unsigned char* kb_next, bool has_next, const LAS unsigned char* vb, const int (&ko)[4], int vo0, int vo1) {
    bf16x8 vf[8];
#pragma unroll
    for (int cb = 0; cb < 4; ++cb) { vf[cb] = *(const LAS bf16x8*)(vb + vo0 + cb * 4096); vf[4 + cb] = *(const LAS bf16x8*)(vb + vo1 + cb * 4096); }
    __builtin_amdgcn_sched_barrier(0);
    sn = negm;
#pragma unroll
    for (int ds = 0; ds < 4; ++ds) sn = MFMA32(kf[ds], qf[ds], sn);
    if (has_next) {
#pragma unroll
        for (int ds = 0; ds < 4; ++ds) kf[ds] = *(const LAS bf16x8*)(kb_next + ko[ds]);
    }
    __builtin_amdgcn_sched_barrier(0);
    float mx = max3f(sc[0], sc[1], sc[2]), my = max3f(sc[3], sc[4], sc[5]);
    mx = max3f(mx, sc[6], sc[7]); my = max3f(my, sc[8], sc[9]); mx = max3f(mx, sc[10], sc[11]); my = max3f(my, sc[12], sc[13]); mx = max3f(mx, sc[14], sc[15]);
    mrun = max3f(mrun, mx, my);
    float ps = 0.f;
#pragma unroll
    for (int i = 0; i < 16; ++i) { sc[i] = ex2(sc[i]); ps += sc[i]; }
    lsum += ps;
    u32x4 w0, w1;
    w0.x = pk2(sc[0], sc[1]); w0.y = pk2(sc[2], sc[3]); w0.z = pk2(sc[4], sc[5]); w0.w = pk2(sc[6], sc[7]);
    w1.x = pk2(sc[8], sc[9]); w1.y = pk2(sc[10], sc[11]); w1.z = pk2(sc[12], sc[13]); w1.w = pk2(sc[14], sc[15]);
    const bf16x8 pf0 = __builtin_bit_cast(bf16x8, w0), pf1 = __builtin_bit_cast(bf16x8, w1);
#pragma unroll
    for (int cb = 0; cb < 4; ++cb) O[cb] = MFMA32(vf[cb], pf0, O[cb]);
#pragma unroll
    for (int cb = 0; cb < 4; ++cb) O[cb] = MFMA32(vf[4 + cb], pf1, O[cb]);
}
DI void attn_renorm(f32x16& spend, f32x16 (&O)[4], f32x16& negm, float& mref, float& lsum, float& mrun) {
    constexpr float THR = 6.0f;
    const float mx = swap_max(mrun);
    if (__any(mx > THR)) {
        const float dl = fmaxf(mx, 0.f), alpha = ex2(-dl);
        mref += dl; lsum *= alpha;
#pragma unroll
        for (int cb = 0; cb < 4; ++cb) O[cb] = O[cb] * alpha;
#pragma unroll
        for (int i = 0; i < 16; ++i) { spend[i] -= dl; negm[i] = -mref; }
    }
    mrun = -1.0e30f;
}

DI void diff_attn_phase(int wv, LAS unsigned char* lds, const bf16_t* QK, const bf16_t* VT, int rows, int nb, int S, bf16_t* OUT, const float* lq1, const float* lk1, const float* lq2, const float* lk2, float lam0, float lam1, int layer, const float* gsub) {
    const int tid = get_tid(wv);
    asm volatile("" : "+s"(layer));
    float lam_i = layer == 0 ? lam0 : lam1;
    const int lane = tid & 63, r = lane & 31, hi = lane >> 5, wid = __builtin_amdgcn_readfirstlane(tid >> 6), map = wid >> 2, qsub = wid & 3;
    lam_i = __uint_as_float(__builtin_amdgcn_readfirstlane(__float_as_uint(lam_i)));
    constexpr int KBYTES = 16384, STG = 32768;
    const int nqb = S / 128, nunits = nb * 4 * nqb, NT = S / 64;
    const int pr = (r & 0x13) | ((r & 4) << 1) | ((r & 8) >> 1);
    int ko[4], vo[4];
#pragma unroll
    for (int i = 0; i < 4; ++i) { ko[i] = pr * 256 + (((map * 8 + 2 * i + hi) ^ (pr & 15)) << 4); vo[i] = r * 128 + (((2 * i + hi) ^ ((r >> 1) & 7)) << 4); }
    unsigned kofs[2], vofs[2];
#pragma unroll
    for (int i = 0; i < 2; ++i) { const int L = wid * 1024 + i * 8192 + lane * 16;
        const int kr_ = L >> 8, kc_ = ((L >> 4) & 15) ^ (kr_ & 15); kofs[i] = (unsigned)(kr_ * 4096 + kc_ * 16);
        const int vr_ = L >> 7, vc_ = ((L >> 4) & 7) ^ ((vr_ >> 1) & 7); vofs[i] = (unsigned)vr_ * (unsigned)rows * 2u + (unsigned)(vc_ * 16); }
    const unsigned dml = wid * 1024;
    const int upx = nunits >> 3, xcd = blockIdx.x & 7, xj = blockIdx.x >> 3, xstride = gridDim.x >> 3;
    for (int k = xj; k < upx; k += xstride) {
        const int u = xcd * upx + k;
        const int qb = u & (nqb - 1), bh = u >> __builtin_ctz(nqb), h = bh & 3, b = bh >> 2;
        const size_t seq0 = (size_t)b * S;
        bf16x8 qf[4];
        { const int ln = get_tid(wv) & 63;
          const bf16_t* qp = QK + (seq0 + qb * 128 + qsub * 32 + (ln & 31)) * 2048 + (2 * h + map) * 64 + 8 * (ln >> 5);
#pragma unroll
          for (int ds = 0; ds < 4; ++ds) qf[ds] = *(const GAS bf16x8*)(qp + 16 * ds); }
        const char* kbase = (const char*)(QK + seq0 * 2048 + 512 + 128 * h);
        const char* vbase = (const char*)(VT + (size_t)(128 * h) * rows + seq0);
#define KS(j) (lds + (j) * 16384)
#define VS(j) (lds + 65536 + (j) * 16384)
#define CLT(t) ((t) < NT ? (t) : NT - 1)
#define DMA_KH(t, hf) do { const int t_ = CLT(t); glds16_s(kbase + (size_t)t_ * (64 * 4096), kofs[hf], (unsigned)(size_t)(KS((t) & 3) + dml + (hf) * 8192)); } while (0)
#define DMA_V(t) do { const char* b_ = vbase + (size_t)CLT(t) * 128; _Pragma("unroll") for (int i_ = 0; i_ < 2; ++i_) glds16_s(b_, vofs[i_], (unsigned)(size_t)(VS((t) & 3) + dml + i_ * 8192)); } while (0)
        f32x16 O[4];
#pragma unroll
        for (int cb = 0; cb < 4; ++cb)
#pragma unroll
            for (int i = 0; i < 16; ++i) O[cb][i] = 0.f;
        DMA_KH(0, 0); DMA_KH(0, 1); DMA_V(0); DMA_KH(1, 0); DMA_KH(1, 1); DMA_KH(2, 0); DMA_V(1);
        asm volatile("s_waitcnt vmcnt(0)" ::: "memory"); __syncthreads();
        f32x16 sa, sb, negm;
#pragma unroll
        for (int i = 0; i < 16; ++i) sa[i] = 0.f;
#pragma unroll
        for (int ds = 0; ds < 4; ++ds) sa = MFMA32(*(const LAS bf16x8*)(lds + ko[ds]), qf[ds], sa);
        float mref, lsum = 0.f, mrun = -1.0e30f;
        { float mx = fmaxf(sa[0], sa[1]);
#pragma unroll
          for (int i = 2; i < 16; ++i) mx = fmaxf(mx, sa[i]);
          mref = swap_max(mx);
#pragma unroll
          for (int i = 0; i < 16; ++i) { sa[i] -= mref; negm[i] = -mref; } }
        __syncthreads();
        for (int a = 0; a < NT; a += 4) {
            DMA_KH(a + 2, 1); DMA_KH(a + 3, 0); DMA_KH(a + 3, 1); DMA_KH(a + 4, 0); DMA_V(a + 2); DMA_V(a + 3);
            bf16x8 kf[4];
#pragma unroll
            for (int ds = 0; ds < 4; ++ds) kf[ds] = *(const LAS bf16x8*)(KS(0) + 8192 + ko[ds]);
            attn_step32(sa, sb, O, negm, lsum, mrun, qf, kf, KS(1), true, VS(0), ko, vo[0], vo[1]);
            attn_step32(sb, sa, O, negm, lsum, mrun, qf, kf, KS(1) + 8192, true, VS(0), ko, vo[2], vo[3]);
            attn_step32(sa, sb, O, negm, lsum, mrun, qf, kf, KS(2), true, VS(1), ko, vo[0], vo[1]);
            attn_step32(sb, sa, O, negm, lsum, mrun, qf, kf, KS(0), false, VS(1), ko, vo[2], vo[3]);
            attn_renorm(sa, O, negm, mref, lsum, mrun);
            asm volatile("s_waitcnt vmcnt(0)" ::: "memory"); __syncthreads();
            DMA_KH(a + 4, 1); DMA_KH(a + 5, 0); DMA_KH(a + 5, 1); DMA_KH(a + 6, 0); DMA_V(a + 4); DMA_V(a + 5);
#pragma unroll
            for (int ds = 0; ds < 4; ++ds) kf[ds] = *(const LAS bf16x8*)(KS(2) + 8192 + ko[ds]);
            attn_step32(sa, sb, O, negm, lsum, mrun, qf, kf, KS(3), true, VS(2), ko, vo[0], vo[1]);
            attn_step32(sb, sa, O, negm, lsum, mrun, qf, kf, KS(3) + 8192, true, VS(2), ko, vo[2], vo[3]);
            attn_step32(sa, sb, O, negm, lsum, mrun, qf, kf, KS(0), true, VS(3), ko, vo[0], vo[1]);
            attn_step32(sb, sa, O, negm, lsum, mrun, qf, kf, KS(0), false, VS(3), ko, vo[2], vo[3]);
            attn_renorm(sa, O, negm, mref, lsum, mrun);
            asm volatile("s_waitcnt vmcnt(0)" ::: "memory"); __syncthreads();
        }
#undef DMA_KH
#undef DMA_V
#undef KS
#undef VS
#undef CLT
        lsum = swap_sum(lsum);
        const float inv = __builtin_amdgcn_rcpf(lsum);
        LAS float* X = (LAS float*)lds;
        if (map == 1) {
            const int lane = get_tid(wv) & 63;
#pragma unroll
            for (int cb = 0; cb < 4; ++cb)
#pragma unroll
                for (int i = 0; i < 16; ++i) X[((qsub * 4 + cb) * 16 + i) * 64 + lane] = O[cb][i] * inv;
        }
        __syncthreads();
        if (map == 0) {
            const int lane = get_tid(wv) & 63, r = lane & 31, hi = lane >> 5;
            float li = lam_i; asm volatile("" : "+s"(li));
            const float lam = __expf(wave_sum(lq1[lane] * lk1[lane], lane)) - __expf(wave_sum(lq2[lane] * lk2[lane], lane)) + li;
            const float oml = 1.0f - li;
            float ss = 0.f;
#pragma unroll
            for (int cb = 0; cb < 4; ++cb)
#pragma unroll
                for (int i = 0; i < 16; ++i) { const float d = O[cb][i] * inv - lam * X[((qsub * 4 + cb) * 16 + i) * 64 + lane]; O[cb][i] = d; ss += d * d; }
            ss = swap_sum(ss);
            const float rstd = oml * __builtin_amdgcn_rsqf(ss * (1.0f / 128.0f) + RMS_EPS);
            bf16_t* orow = OUT + (seq0 + qb * 128 + qsub * 32 + r) * 1024 + h * 128 + 4 * hi;
#pragma unroll
            for (int cb = 0; cb < 4; ++cb)
#pragma unroll
                for (int j4 = 0; j4 < 4; ++j4) { const f32x4 gg = *(const GAS f32x4*)(gsub + 32 * cb + 8 * j4 + 4 * hi);
                    u32x2 w; w.x = pk2(O[cb][4 * j4] * rstd * gg.x, O[cb][4 * j4 + 1] * rstd * gg.y); w.y = pk2(O[cb][4 * j4 + 2] * rstd * gg.z, O[cb][4 * j4 + 3] * rstd * gg.w);
                    *(GAS u32x2*)(orow + 32 * cb + 8 * j4) = w; }
        }
        __syncthreads();
    }
}

DI void dil_phase(int wv, const bf16_t* QK, const bf16_t* VTg, int rows, int nb, int S, int rr, int pat, bf16_t* OUT, float* LSE) {
    const int tid = get_tid(wv);
    const int lane = tid & 63, r = lane & 31, hi = lane >> 5, wid = __builtin_amdgcn_readfirstlane(tid >> 6);
    const int pr = (r & 0x13) | ((r & 4) << 1) | ((r & 8) >> 1);
    const int Sr = S >> __builtin_ctz(rr), ublk = Sr / 32, per_sh = S / 32, nunits = nb * 8 * per_sh;
    const int upx = nunits >> 3, xcd = blockIdx.x & 7, lw = (blockIdx.x >> 3) * 8 + wid, lstride = (gridDim.x >> 3) * 8;
    for (int k = lw; k < upx; k += lstride) {
        const int wu = xcd * upx + k;
        const int inner = wu & (per_sh - 1), sh = wu >> __builtin_ctz(per_sh), head = sh & 7, seq = sh >> 3;
        const int cls = inner >> __builtin_ctz(ublk), i0 = (inner & (ublk - 1)) * 32;
        const size_t seq0 = (size_t)seq * S;
        const int qtok = cls + rr * (i0 + r);
        const bf16_t* qp = QK + (seq0 + qtok) * 2048 + 1024 + head * 64 + 8 * hi;
        const bf16_t* kbase = QK + (seq0 + cls) * 2048 + 1536 + head * 64 + 8 * hi;
        const bf16_t* vbase = VTg + (size_t)head * rows * 64 + ((seq0 + (size_t)cls * Sr) >> 3) * 512 + r * 8;
        bf16_t* orow = OUT + (seq0 + qtok) * 1024 + 512 + head * 64 + 4 * hi;
        GAS float* lsep = (GAS float*)(LSE + (seq0 + qtok) * 8 + head);
        bf16x8 qf[4];
#pragma unroll
        for (int ds = 0; ds < 4; ++ds) qf[ds] = *(const GAS bf16x8*)(qp + 16 * ds);
        bf16x8 kf[4], vf[4], kn[4], vn[4];
#define DIL_LOAD(KF, VF, kb) do { int mk_ = i0 - 64 + 32 * (kb) + pr; mk_ = mk_ < 0 ? 0 : (mk_ >= Sr ? Sr - 1 : mk_); const bf16_t* kp_ = kbase + (size_t)rr * mk_ * 2048; \
            _Pragma("unroll") for (int ds_ = 0; ds_ < 4; ++ds_) KF[ds_] = *(const GAS bf16x8*)(kp_ + 16 * ds_); \
            _Pragma("unroll") for (int s8_ = 0; s8_ < 2; ++s8_) { int m0_ = i0 - 64 + 16 * (2 * (kb) + s8_) + 8 * hi; m0_ = (m0_ < 0 || m0_ >= Sr) ? 0 : m0_; \
                _Pragma("unroll") for (int cb_ = 0; cb_ < 2; ++cb_) VF[s8_ * 2 + cb_] = *(const GAS bf16x8*)(vbase + (size_t)(m0_ >> 3) * 512 + cb_ * 256); } } while (0)
        DIL_LOAD(kf, vf, 0);
        f32x16 O[2]; float mrun, lrun;
        if (pat > 0) {
            mrun = *lsep; lrun = hi == 0 ? 1.0f : 0.0f;
#pragma unroll
            for (int cb = 0; cb < 2; ++cb)
#pragma unroll
                for (int j4 = 0; j4 < 4; ++j4) { const u32x2 w = *(const GAS u32x2*)(orow + 32 * cb + 8 * j4);
                    O[cb][4 * j4] = bf_lo(w.x); O[cb][4 * j4 + 1] = bf_hi(w.x); O[cb][4 * j4 + 2] = bf_lo(w.y); O[cb][4 * j4 + 3] = bf_hi(w.y); }
        } else {
            mrun = -1.0e30f; lrun = 0.f;
#pragma unroll
            for (int cb = 0; cb < 2; ++cb)
#pragma unroll
                for (int i = 0; i < 16; ++i) O[cb][i] = 0.f;
        }
#pragma unroll
        for (int kb = 0; kb < 5; ++kb) {
            if (kb < 4) DIL_LOAD(kn, vn, kb + 1);
            f32x16 sc;
#pragma unroll
            for (int i = 0; i < 16; ++i) sc[i] = 0.f;
#pragma unroll
            for (int ds = 0; ds < 4; ++ds) sc = MFMA32(kf[ds], qf[ds], sc);
            float mx = -3.0e38f;
#pragma unroll
            for (int i = 0; i < 16; ++i) {
                const int kk = 32 * kb + 16 * (i >> 3) + 8 * hi + (i & 7), mk = i0 - 64 + kk, dd = kk - r;
                const bool ok = (mk >= 0) && (mk < Sr) && (dd >= 0) && (dd <= 128);
                const float v = ok ? sc[i] : -INFINITY; sc[i] = v; mx = fmaxf(mx, v);
            }
            mx = swap_max(mx);
            const float mnew = fmaxf(mrun, mx), alpha = ex2(mrun - mnew);
            float ps = 0.f;
#pragma unroll
            for (int i = 0; i < 16; ++i) { const float p = ex2(sc[i] - mnew); sc[i] = p; ps += p; }
            lrun = lrun * alpha + ps; mrun = mnew;
#pragma unroll
            for (int cb = 0; cb < 2; ++cb) O[cb] = O[cb] * alpha;
            u32x4 w0, w1;
            w0.x = pk2(sc[0], sc[1]); w0.y = pk2(sc[2], sc[3]); w0.z = pk2(sc[4], sc[5]); w0.w = pk2(sc[6], sc[7]);
            w1.x = pk2(sc[8], sc[9]); w1.y = pk2(sc[10], sc[11]); w1.z = pk2(sc[12], sc[13]); w1.w = pk2(sc[14], sc[15]);
            const bf16x8 pf0 = __builtin_bit_cast(bf16x8, w0), pf1 = __builtin_bit_cast(bf16x8, w1);
#pragma unroll
            for (int cb = 0; cb < 2; ++cb) { O[cb] = MFMA32(vf[cb], pf0, O[cb]); O[cb] = MFMA32(vf[2 + cb], pf1, O[cb]); }
            if (kb < 4) {
#pragma unroll
                for (int i = 0; i < 4; ++i) { kf[i] = kn[i]; vf[i] = vn[i]; }
            }
        }
#undef DIL_LOAD
        const float lt = swap_sum(lrun), inv = __builtin_amdgcn_rcpf(lt);
#pragma unroll
        for (int cb = 0; cb < 2; ++cb)
#pragma unroll
            for (int j4 = 0; j4 < 4; ++j4) { u32x2 w; w.x = pk2(O[cb][4 * j4] * inv, O[cb][4 * j4 + 1] * inv); w.y = pk2(O[cb][4 * j4 + 2] * inv, O[cb][4 * j4 + 3] * inv); *(GAS u32x2*)(orow + 32 * cb + 8 * j4) = w; }
        if (hi == 0) *lsep = mrun + __log2f(lt);
    }
}

#define XB_TMO      128
#define XB_XCNT(j)  (256  + 64 * (j))
#define XB_XSUB(j)  (1280 + 64 * (j))
#define XB_XGEN(j)  (2304 + 64 * (j))
#define XB_TOP      3328
#define XB_TOPGEN   3392
#define XCD_BAR_WORDS 3456
#define XB_SPIN_CAP (1u << 20)
DI unsigned xb_ld(unsigned* p)              { return __hip_atomic_load(p, __ATOMIC_RELAXED, __HIP_MEMORY_SCOPE_AGENT); }
DI unsigned xb_add(unsigned* p, unsigned v) { return __hip_atomic_fetch_add(p, v, __ATOMIC_RELAXED, __HIP_MEMORY_SCOPE_AGENT); }
DI unsigned xb_xcc_id() { return (unsigned)__builtin_amdgcn_s_getreg((3 << 11) | 20) & 0xFu; }
#define XB_SPIN(cond, bar) do { unsigned _sp = 0; while (cond) { __builtin_amdgcn_s_sleep(1); \
    if ((++_sp & 255u) == 0u) { if (xb_ld(&(bar)[XB_TMO])) break; if (_sp > XB_SPIN_CAP) { atomicAdd(&(bar)[XB_TMO], 1u); break; } } } } while (0)
struct XcdBarrier { unsigned* bar; unsigned x; volatile LAS unsigned* st; };
DI bool is_thread0(int wv) { unsigned z; asm volatile("s_mov_b32 %0, 0" : "=s"(z)); return wv == 0 && __builtin_amdgcn_mbcnt_hi(~0u, __builtin_amdgcn_mbcnt_lo(~0u, z)) == 0u; }
DI XcdBarrier xcd_barrier_post(unsigned* bar, volatile LAS unsigned* st, int wv) {
    XcdBarrier b; b.bar = bar; b.x = xb_xcc_id(); b.st = st;
    if (is_thread0(wv)) (void)xb_add(&bar[XB_XCNT(b.x)], 1u);
    return b;
}
DI void xcd_barrier_complete(unsigned* bar, unsigned x, unsigned& nloc, unsigned& nx) {
    const unsigned G = gridDim.x * gridDim.y * gridDim.z;
    unsigned sum, cnt, mine, sp = 0u;
    for (;;) {
        sum = 0u; cnt = 0u; mine = 0u;
#pragma unroll
        for (unsigned j = 0; j < 16; ++j) { const unsigned c = xb_ld(&bar[XB_XCNT(j)]); sum += c; cnt += (c > 0u) ? 1u : 0u; mine = (j == x) ? c : mine; }
        if (sum == G) break;
        __builtin_amdgcn_s_sleep(1);
        if ((++sp & 255u) == 0u) { if (xb_ld(&bar[XB_TMO])) break; if (sp > XB_SPIN_CAP) { atomicAdd(&bar[XB_TMO], 1u); break; } }
    }
    nloc = mine > 0u ? mine : 1u; nx = cnt > 0u ? cnt : 1u;
}
DI void xcd_barrier(const XcdBarrier& b, int wv) {
    asm volatile("s_waitcnt vmcnt(0)" ::: "memory");
    __syncthreads();
    if (is_thread0(wv)) {
        unsigned* bar = b.bar;
        __builtin_amdgcn_s_waitcnt(0);
        unsigned nloc = b.st[0], nx = b.st[1];
        if (nloc == 0u) { xcd_barrier_complete(bar, b.x, nloc, nx); b.st[0] = nloc; b.st[1] = nx; }
        const unsigned old = xb_add(&bar[XB_XSUB(b.x)], 1u);
        const unsigned gen = old / nloc;
        if (old + 1u == (gen + 1u) * nloc) {
            __builtin_amdgcn_fence(__ATOMIC_RELEASE, "agent");
            asm volatile("s_waitcnt vmcnt(0)" ::: "memory");
            const unsigned og = xb_add(&bar[XB_TOP], 1u);
            const unsigned tg = og / nx;
            if (og + 1u == (tg + 1u) * nx) xb_add(&bar[XB_TOPGEN], 1u);
            else XB_SPIN(xb_ld(&bar[XB_TOPGEN]) == tg, bar);
            __builtin_amdgcn_fence(__ATOMIC_ACQUIRE, "agent");
            xb_add(&bar[XB_XGEN(b.x)], 1u);
            asm volatile("s_waitcnt vmcnt(0)" ::: "memory");
        } else {
            XB_SPIN(xb_ld(&bar[XB_XGEN(b.x)]) == gen, bar);
            __builtin_amdgcn_fence(__ATOMIC_ACQUIRE, "agent");
            asm volatile("s_waitcnt vmcnt(0)" ::: "memory");
        }
    }
    __syncthreads();
}

__global__ void __launch_bounds__(512) fwd_megakernel(Params p) {
    extern __shared__ __attribute__((aligned(16))) unsigned char lds_raw[];
    LAS unsigned char* lds = (LAS unsigned char*)lds_raw;
    LAS unsigned char* scr = lds + LDS_SCR;
    cg::grid_group grid = cg::this_grid();
    LAS unsigned long long* tab = (LAS unsigned long long*)(lds + LDS_SCR + 12288);
    if (threadIdx.x < 25) tab[threadIdx.x] = (unsigned long long)p.in[threadIdx.x];
    if (threadIdx.x == 25) tab[25] = (unsigned long long)p.out;
    if (threadIdx.x == 26) tab[26] = (unsigned long long)p.ws;
    if (threadIdx.x >= 32 && threadIdx.x < 36) ((LAS unsigned*)(lds + LDS_SCR + 13312))[threadIdx.x - 32] = 0u;
    __syncthreads();
#define PIN(k) ((const float*)ldptr(tab + (k)))
    const int G = gridDim.x, NGW = G * 8;
    const int wv = __builtin_amdgcn_readfirstlane((int)threadIdx.x >> 6);
    (void)xcd_barrier_post((unsigned*)p.ws, (volatile LAS unsigned*)(lds + LDS_SCR + 13312), wv);
#define GSYNC() do { XcdBarrier gb_; gb_.bar = (unsigned*)ldptr(tab + 26); gb_.x = xb_xcc_id(); gb_.st = (volatile LAS unsigned*)(lds + LDS_SCR + 13312); xcd_barrier(gb_, wv); } while (0)
#define WSB ((unsigned char*)ldptr(tab + 26))
#define cosT ((float*)(WSB + WS_ROPE_C))
#define sinT ((float*)(WSB + WS_ROPE_S))
#define LSE ((float*)(WSB + WS_LSE))
#define WPT(off) ((bf16_t*)(WSB + WS_W + (off)))
#define WQK WPT(W_QK)
#define WV WPT(W_V)
#define WO WPT(W_O)
#define WXQ WPT(W_XQ)
#define WXK WPT(W_XK)
#define WXV WPT(W_XV)
#define WXO WPT(W_XO)
#define WUP WPT(W_UP)
#define WDN WPT(W_DN)
#define MEMN WPT(W_MEMN)
#define KMEM WPT(W_KMEM)
#define VMEM WPT(W_VMEM)
#define BT1 WPT(W_BT1)
#define BT2 WPT(W_BT2)
#define ACT ((bf16_t*)(WSB + WS_ACT))
#define BIG (WSB + WS_BIG)
#define X ((float*)ldptr(tab + 25))

    for (int l = -1; l < 2; ++l) {
      if (l >= 0) {

        const float qscale = 0.125f * LOG2E;

        for (int grp = 0; grp < 2; ++grp) {
            const int row0 = grp == 0 ? 0 : TOK_P, rows = grp == 0 ? TOK_P : TOK_S, nb = grp == 0 ? 4 : 2, S = grp == 0 ? 4096 : 16384;
            bf16_t* QK = (bf16_t*)BIG; bf16_t* VT = (bf16_t*)(BIG + 128 * MiB); bf16_t* VT1 = (bf16_t*)(BIG + 192 * MiB); bf16_t* VT2 = (bf16_t*)(BIG + 224 * MiB);
            const bf16_t* XNg = ACT + (size_t)row0 * DM;
            {
                pg8::Sched Sc;
                if (grp == 0) {
                    Sc.init(MEMN, 1024, 6, WXK, 1024, 4, 1024, 0, 0, 0, 128); pg8::gemm_phase(wv, lds, scr, Sc, pg8::EpiBf16{KMEM, 1024, 256 * 1024, 0, 1.0f});
                    Sc.init(MEMN, 1024, 6, WXV, 1024, 4, 1024, 0, 0, 0, 160); pg8::gemm_phase(wv, lds, scr, Sc, pg8::EpiBf16{VMEM, 1024, 256 * 1024, 0, 1.0f});
                }
                Sc.init(XNg, 1024, rows / 256, WQK, 1024, 8, 1024); pg8::gemm_phase(wv, lds, scr, Sc, pg8::EpiRope{QK, cosT, sinT, S - 1, qscale});
                Sc.init(WV, 1024, 2, XNg, 1024, rows / 256, 1024); pg8::gemm_phase(wv, lds, scr, Sc, pg8::EpiBf16{VT, rows, 256L * rows, 0, 1.0f});
                Sc.init(WV + 512 * 1024, 1024, 2, XNg, 1024, rows / 256, 1024, 0, 0, 0, 64); pg8::gemm_phase(wv, lds, scr, Sc, pg8::EpiVtd{VT + (size_t)512 * rows, rows});
                Sc.init(WV + 512 * 1024, 1024, 2, XNg, 4 * 1024, rows / 256, 1024, 1, S, 4); pg8::gemm_phase(wv, lds, scr, Sc, pg8::EpiVtd{VT1, rows});
                Sc.init(WV + 512 * 1024, 1024, 2, XNg, 16 * 1024, rows / 256, 1024, 1, S, 16, 128); pg8::gemm_phase(wv, lds, scr, Sc, pg8::EpiVtd{VT2, rows});
            }
            GSYNC();
            if (grp == 0) {
                pg8::Sched Sc;
                Sc.init(KMEM, 1024, 24, WXQ, 1024, 4, 256, 3); pg8::gemm_phase(wv, lds, scr, Sc, pg8::EpiBf16{BT1, 1024, 262144, 0, 0.0625f * LOG2E});
                Sc.init(WXO, 1024, 4, VMEM, 1024, 24, 256, 4, 0, 0, 128); pg8::gemm_phase(wv, lds, scr, Sc, pg8::EpiBf16{BT2, 1024, 256 * 1024, 1, 1.0f});
            }
            bf16_t* OUTg = ACT + (size_t)row0 * DM; float* LSEg = LSE + (size_t)row0 * 8;
            diff_attn_phase(wv, lds, QK, VT, rows, nb, S, OUTg, PIN(6) + l * 64, PIN(7) + l * 64, PIN(8) + l * 64, PIN(9) + l * 64, p.lambda_init[0], p.lambda_init[1], l, PIN(10) + l * 128);
            dil_phase(wv, QK, VT + (size_t)512 * rows, rows, nb, S, 1, 0, OUTg, LSEg);
            GSYNC();
            dil_phase(wv, QK, VT1, rows, nb, S, 4, 1, OUTg, LSEg);
            GSYNC();
            dil_phase(wv, QK, VT2, rows, nb, S, 16, 2, OUTg, LSEg);
            GSYNC();
        }
        { pg8::Sched Sc; Sc.init(ACT, 1024, NTOK / 256, WO, 1024, 4, 1024); pg8::gemm_phase(wv, lds, scr, Sc, pg8::EpiBf16{(bf16_t*)BIG, 1024, 256 * 1024, 0, 1.0f}); }
        GSYNC();
        if (l == 0) post_pass(wv, (const bf16_t*)BIG, 0, X, PIN(19), PIN(21), ACT, 0, NTOK, PIN(0), PIN(1));
        else post_pass(wv, (const bf16_t*)BIG, 0, X, PIN(19) + DM, PIN(21) + DM, ACT, 0, NTOK);
        GSYNC();
        { pg8::Sched Sc; Sc.init(ACT, 1024, NTOK / 256, BT1, 1024, 4, 1024, 2); pg8::gemm_phase(wv, lds, scr, Sc, pg8::EpiSoftmax{(bf16_t*)BIG, 1024}); }
        GSYNC();
        { pg8::Sched Sc; Sc.init((const bf16_t*)BIG, 1024, NTOK / 256, BT2, 1024, 4, 1024, 2); pg8::gemm_phase(wv, lds, scr, Sc, pg8::EpiBf16{(bf16_t*)(BIG + 96 * MiB), 1024, 256 * 1024, 0, 1.0f}); }
        GSYNC();
        post_pass(wv, (const bf16_t*)(BIG + 96 * MiB), 0, X, PIN(22) + l * DM, PIN(23) + l * DM, ACT, 0, NTOK);
        GSYNC();
        {
            pg8::Sched Sc; Sc.init(ACT, 1024, 194, WUP, 1024, 22, 1024, 5);
            pg8::gemm_phase(wv, lds, scr, Sc, pg8::EpiConvGate{(bf16_t*)BIG, PIN(15) + (size_t)l * 3 * DFF2, PIN(16) + (size_t)l * DFF2, -1, NTOK}); }
        GSYNC();
        for (int c = 0; c < 4; ++c) {
            const int r0 = c * 16384;
            for (int ph = 0; ph < 2; ++ph) {
                if (c > 0 && ((ph == 0) == ((blockIdx.x & 1) != 0)))
                    post_pass(wv, (bf16_t*)(BIG + (264 + 32 * ((c - 1) & 1)) * MiB), r0 - 16384, X, PIN(24) + l * DM, l == 0 ? PIN(18) + DM : nullptr, ACT, r0 - 16384, r0);
                if (ph == 0 && c < 3) { pg8::Sched Sc; Sc.init((bf16_t*)BIG + (size_t)r0 * DFF, DFF, 64, WDN, DFF, 4, DFF);
                    pg8::gemm_phase(wv, lds, scr, Sc, pg8::EpiBf16{(bf16_t*)(BIG + (264 + 32 * (c & 1)) * MiB), 1024, 256 * 1024, 0, 1.0f}); }
            }
            if (c < 3) GSYNC();
        }
      }
      { const int lS = l + 1;
        if (lS < 2) {
        {
            const int tid = get_tid(wv);
            const int lane = tid & 63, wave = __builtin_amdgcn_readfirstlane(tid >> 6), gw = blockIdx.x * 8 + wave;
            LAS float* tscr = (LAS float*)(lds + wave * 16384);
            const float* w_in = PIN(4) + (size_t)lS * 1024 * 3072; const float* w_out = PIN(5) + (size_t)lS * 1024 * 1024; const float* w_xq = PIN(11) + (size_t)lS * 1024 * 1024;
            const float* w_xkv = PIN(12) + (size_t)lS * 1024 * 2048; const float* w_xo = PIN(13) + (size_t)lS * 1024 * 1024; const float* w_up = PIN(14) + (size_t)lS * 1024 * DFF2; const float* w_dn = PIN(17) + (size_t)lS * DFF * 1024;
            bf16_t* const wqk = WQK; bf16_t* const wo = WO; bf16_t* const wxk = WXK; bf16_t* const wxo = WXO; bf16_t* const wup = WUP; bf16_t* const wdn = WDN; bf16_t* const wxq = WXQ; bf16_t* const memn = MEMN; bf16_t* const act = ACT;
            float* const xo = X; float* const cosp = cosT; float* const sinp = sinT;
            const float* const mem_p = PIN(2); const float* const mem_s = PIN(3); const float* const g_mem = PIN(20) + lS * DM; const float* const x_p = PIN(0); const float* const x_s = PIN(1); const float* const g_pre0 = PIN(18);
            constexpr int I_IN = 16 * 96, I_O = 16 * 32, I_XKV = 16 * 64, I_XO = 16 * 32, I_UP = 16 * 176, I_DN = 44 * 32;
            constexpr int NIT = I_IN + I_O + I_XKV + I_XO + I_UP + I_DN;
            for (int it = gw; it < NIT; it += NGW) {
                int q = it;
                if (q < I_IN) { transpose_item(w_in, 3072, q / 96, (q % 96) * 32, wqk, 1024, tscr, lane, DrowWin{}); continue; } q -= I_IN;
                if (q < I_O) { transpose_item(w_out, 1024, q / 32, (q % 32) * 32, wo, 1024, tscr, lane, DrowId{0}); continue; } q -= I_O;
                if (q < I_XKV) { transpose_item(w_xkv, 2048, q / 64, (q % 64) * 32, wxk, 1024, tscr, lane, DrowId{0}); continue; } q -= I_XKV;
                if (q < I_XO) { transpose_item(w_xo, 1024, q / 32, (q % 32) * 32, wxo, 1024, tscr, lane, DrowId{0}); continue; } q -= I_XO;
                if (q < I_UP) { transpose_item(w_up, DFF2, q / 176, (q % 176) * 32, wup, 1024, tscr, lane, DrowUp{}); continue; } q -= I_UP;
                transpose_item(w_dn, 1024, q / 32, (q % 32) * 32, wdn, DFF, tscr, lane, DrowId{0});
            }
            for (int i = blockIdx.x * 512 + tid; i < 1024 * 1024 / 8; i += G * 512) { const f32x4 a = ((const GAS f32x4*)w_xq)[2 * i], b = ((const GAS f32x4*)w_xq)[2 * i + 1];
                u32x4 w; w.x = pk2(a.x, a.y); w.y = pk2(a.z, a.w); w.z = pk2(b.x, b.y); w.w = pk2(b.z, b.w); ((GAS u32x4*)wxq)[i] = w; }
            for (int row = gw; row < 1536; row += NGW) { const float* src = row < 1024 ? mem_p + (size_t)row * DM : mem_s + (size_t)(row - 1024) * DM;
                f32x4 v[4];
#pragma unroll
                for (int j = 0; j < 4; ++j) v[j] = ((const GAS f32x4*)src)[lane + 64 * j];
                norm_row_bf16(v, g_mem, memn + (size_t)row * DM, lane); }
            if (lS == 0) {
                for (int row = gw; row < NTOK; row += NGW) { const float* src = row < TOK_P ? x_p + (size_t)row * DM : x_s + (size_t)(row - TOK_P) * DM;
                    f32x4 v[4];
#pragma unroll
                    for (int j = 0; j < 4; ++j) v[j] = ((const GAS f32x4*)src)[lane + 64 * j];
                    norm_row_bf16(v, g_pre0, act + (size_t)row * DM, lane); }
                for (int i = blockIdx.x * 512 + tid; i < 16384 * 32; i += G * 512) {
                    const int pos = i >> 5, f = i & 31; const double ang = (double)pos * p.inv_freq[f];
                    const double k = rint(ang * 0.15915494309189535); double rd = fma(-k, 6.283185307179586, ang); rd = fma(-k, 2.4492935982947064e-16, rd);
                    const double x2 = rd * rd; double sn = 1.0, cs = 1.0;
#pragma unroll
                    for (int n = 14; n >= 1; --n) { sn = 1.0 - sn * x2 * (1.0 / (double)((2 * n) * (2 * n + 1))); cs = 1.0 - cs * x2 * (1.0 / (double)((2 * n - 1) * (2 * n))); }
                    cosp[i] = (float)cs; sinp[i] = (float)(sn * rd);
                }
            }
        }
        }
      }
      if (l == -1) grid.sync(); else if (l == 0) GSYNC();
    }
}

extern "C" void kernel_launch(void* const* d_in, const int* in_sizes, int n_in, void* d_out, int out_size, void* d_ws, size_t ws_size, hipStream_t stream) {
    static int grid_blocks = 0;
    if (grid_blocks == 0) {
        if (n_in != 25 || out_size != NTOK * DM || ws_size < WS_END) { fprintf(stderr, "kernel_launch: unexpected shapes (n_in %d out %d ws %zu)\n", n_in, out_size, ws_size); grid_blocks = -1; return; }
        int dev = 0, cus = 0, per_cu = 0;
        hipGetDevice(&dev);
        hipDeviceGetAttribute(&cus, hipDeviceAttributeMultiprocessorCount, dev);
        hipFuncSetAttribute((const void*)fwd_megakernel, hipFuncAttributeMaxDynamicSharedMemorySize, LDS_BYTES);
        hipOccupancyMaxActiveBlocksPerMultiprocessor(&per_cu, (const void*)fwd_megakernel, 512, LDS_BYTES);
        if (per_cu < 1) per_cu = 1;
        grid_blocks = cus * per_cu;
        (void)hipGetLastError();
    }
    if (grid_blocks < 0) return;
    Params p{};
    for (int i = 0; i < 25; ++i) p.in[i] = (const float*)d_in[i];
    p.out = (float*)d_out; p.ws = (unsigned char*)d_ws;
    for (int i = 0; i < 32; ++i) p.inv_freq[i] = 1.0 / std::pow(10000.0, (double)(2 * i) / 64.0);
    p.lambda_init[0] = (float)(0.8 - 0.6 * std::exp(-0.3 * 0.0)); p.lambda_init[1] = (float)(0.8 - 0.6 * std::exp(-0.3 * 1.0));
    (void)hipMemsetAsync(d_ws, 0, 65536, stream);
    void* args[] = {&p};
    hipError_t e = hipLaunchCooperativeKernel((const void*)fwd_megakernel, dim3(grid_blocks), dim3(512), args, LDS_BYTES, stream);
    if (e != hipSuccess) fprintf(stderr, "cooperative launch failed: %s (grid %d)\n", hipGetErrorString(e), grid_blocks);
}
```

```cpp
#include <hip/hip_runtime.h>
#include <hip/hip_cooperative_groups.h>
#include <cstdio>
#include <cstdint>
#include <cmath>
namespace cg = cooperative_groups;

#define LAS __attribute__((address_space(3)))
#define DI __device__ __forceinline__
#define GAS __attribute__((address_space(1)))
typedef unsigned short bf16_t;
typedef short bf16x8 __attribute__((ext_vector_type(8)));
typedef float f32x4 __attribute__((ext_vector_type(4)));
typedef float f32x2 __attribute__((ext_vector_type(2)));
typedef float f32x16 __attribute__((ext_vector_type(16)));
typedef unsigned u32x4 __attribute__((ext_vector_type(4)));
typedef unsigned u32x2 __attribute__((ext_vector_type(2)));
typedef __bf16 bf16x2_t __attribute__((ext_vector_type(2)));

constexpr int DM = 1024;
constexpr int NTOK = 49152, TOK_P = 16384, TOK_S = 32768;
constexpr int DFF = 2816, DFF2 = 5632;
constexpr float RMS_EPS = 1e-6f;
constexpr float LOG2E = 1.4426950408889634f;
constexpr size_t MiB = 1u << 20;
constexpr size_t WS_ROPE_C = 2 * MiB, WS_ROPE_S = 4 * MiB, WS_LSE = 6 * MiB;
constexpr size_t WS_W = 8 * MiB;
constexpr size_t W_QK = 0, W_V = 4 * MiB, W_O = 6 * MiB, W_XQ = 8 * MiB, W_XK = 10 * MiB, W_XV = 12 * MiB, W_XO = 14 * MiB, W_UP = 16 * MiB, W_DN = 27 * MiB,
                 W_MEMN = 33 * MiB, W_KMEM = 36 * MiB, W_VMEM = 39 * MiB, W_BT1 = 42 * MiB, W_BT2 = 54 * MiB;
constexpr size_t WS_ACT = 74 * MiB;
constexpr size_t WS_BIG = 170 * MiB;
constexpr size_t WS_END = 498 * MiB;
constexpr int LDS_BYTES = 147456;
constexpr int LDS_SCR = 131072;

struct Params {
    const float* in[25];
    float* out;
    unsigned char* ws;
    double inv_freq[32];
    float lambda_init[2];
    int pad[2];
};

DI unsigned pk2(float lo, float hi) { f32x2 v = {lo, hi}; bf16x2_t b = __builtin_convertvector(v, bf16x2_t); return __builtin_bit_cast(unsigned, b); }
DI float bf_lo(unsigned u) { return __uint_as_float(u << 16); }
DI float bf_hi(unsigned u) { return __uint_as_float(u & 0xffff0000u); }
DI float shx(float v, int o, int lane) { return __uint_as_float((unsigned)__builtin_amdgcn_ds_bpermute((lane ^ o) << 2, (int)__float_as_uint(v))); }
DI float wave_sum(float v, int lane) {
#pragma unroll
    for (int o = 1; o < 64; o <<= 1) v += shx(v, o, lane);
    return v;
}
DI float swap_max(float m) { auto rr = __builtin_amdgcn_permlane32_swap(__float_as_uint(m), __float_as_uint(m), false, false); return fmaxf(__uint_as_float(rr[0]), __uint_as_float(rr[1])); }
DI float swap_sum(float m) { auto rr = __builtin_amdgcn_permlane32_swap(__float_as_uint(m), __float_as_uint(m), false, false); return __uint_as_float(rr[0]) + __uint_as_float(rr[1]); }
DI float max3f(float a, float b, float c) { float r; asm("v_max3_f32 %0, %1, %2, %3" : "=v"(r) : "v"(a), "v"(b), "v"(c)); return r; }
DI float ex2(float x) { return __builtin_amdgcn_exp2f(x); }
DI int get_tid(int w) { unsigned z; asm volatile("s_mov_b32 %0, 0" : "=s"(z)); const int ln = __builtin_amdgcn_mbcnt_hi(~0u, __builtin_amdgcn_mbcnt_lo(~0u, z)); int t = w * 64 + ln; asm volatile("" : "+v"(t)); return t; }
DI void* ldptr(const LAS unsigned long long* t) { unsigned z; asm volatile("s_mov_b32 %0, 0" : "=s"(z)); const unsigned long long v = *(const LAS unsigned long long*)(size_t)((unsigned)(size_t)t + z); const unsigned lo = __builtin_amdgcn_readfirstlane((unsigned)v), hi = __builtin_amdgcn_readfirstlane((unsigned)(v >> 32)); return (void*)(((unsigned long long)hi << 32) | lo); }
#define MFMA32(a, b, c) __builtin_amdgcn_mfma_f32_32x32x16_bf16((a), (b), (c), 0, 0, 0)

namespace pg8 {
constexpr int BM = 256, BK = 64, HALF = 128, HTB = HALF * BK * 2, STAGE_BYTES = 8 * HTB, NXCD = 8, WGM = 8;
__host__ __device__ __forceinline__ int lds_byte(int r, int c) { const int st = (r >> 4) * 2 + (c >> 5), rr = r & 15, cc = c & 31, ob = rr * 64 + cc * 2; return st * 1024 + (ob ^ (((ob >> 9) & 1) << 5)); }
__host__ __device__ __forceinline__ void stage_rc(int b, int& R, int& C) { const int st = b / 1024, sb = b % 1024, swz = sb ^ (((sb >> 9) & 1) << 5); R = (st >> 1) * 16 + swz / 64; C = (st & 1) * 32 + (swz % 64) / 2; }
__host__ __device__ __forceinline__ int perm32(int rho) { const int n = rho >> 4, i = rho & 15; return 8 * (i >> 2) + 4 * n + (i & 3); }

struct Unit { int pm, pn; };

struct Sched {
    const bf16_t* A; const bf16_t* B; int lda, ldb, K; int nM, nN, nwg, G, c; int mode, p0, p1;
    DI void init(const bf16_t* A_, int lda_, int nM_, const bf16_t* B_, int ldb_, int nN_, int K_, int mode_ = 0, int p0_ = 0, int p1_ = 0, int coff = 0) {
        A = A_; B = B_; lda = lda_; ldb = ldb_; K = K_; nM = nM_; nN = nN_; nwg = nM * nN; G = gridDim.x; c = (int)((blockIdx.x + (unsigned)coff) % gridDim.x); mode = mode_; p0 = p0_; p1 = p1_;
    }
    DI bool next(int i, Unit& u) const {
        const long L = (long)i * G + c; if (L >= nwg) return false;
        int wgid = (int)L; { const int q = nwg / NXCD, r = nwg % NXCD, xcd = wgid % NXCD, off = wgid / NXCD; wgid = (xcd < r ? xcd * (q + 1) : r * (q + 1) + (xcd - r) * q) + off; }
        const int nig = WGM * nN, gid = wgid / nig, fm = gid * WGM, gsz = (nM - fm) < WGM ? (nM - fm) : WGM;
        u.pm = fm + ((wgid % nig) % gsz); u.pn = (wgid % nig) / gsz; return true;
    }
    DI const char* baseA(const Unit& u) const {
        if (mode == 3) return (const char*)(A + (size_t)(u.pm >> 2) * 256 * 1024 + (u.pm & 3) * 256);
        if (mode == 4) return (const char*)(A + (size_t)u.pm * 256 * 1024 + (u.pn & 3) * 256);
        if (mode == 5) return (const char*)(A + ((long)254 * u.pm - 1) * lda);
        return (const char*)(A + (size_t)u.pm * 256 * lda);
    }
    DI const char* baseB(const Unit& u) const {
        if (mode == 1) { const int S = p0, rr = p1, Sr = S >> __builtin_ctz(rr); const int pos = u.pn * 256, seq = pos >> __builtin_ctz(S), within = pos & (S - 1), cls = within >> __builtin_ctz(Sr), m0 = within & (Sr - 1);
            return (const char*)(B + ((size_t)seq * S + (size_t)m0 * rr + cls) * 1024); }
        if (mode == 2) { const int b = u.pm < 64 ? (u.pm >> 4) : 4 + ((u.pm - 64) >> 6); return (const char*)(B + (size_t)b * 1048576 + (size_t)u.pn * 256 * 1024); }
        if (mode == 3) return (const char*)(B + (size_t)u.pn * 256 * 1024 + (u.pm & 3) * 256);
        if (mode == 4) return (const char*)(B + (size_t)(u.pn >> 2) * 256 * 1024 + (u.pn & 3) * 256);
        return (const char*)(B + (size_t)u.pn * 256 * ldb);
    }
};

typedef f32x4 Acc[2][2][4][2];

struct EpiBf16 {
    static constexpr bool PERM = true;
    bf16_t* O; long ldc; long pm_stride; int pnmode; float scale;
    DI void operator()(const Acc& acc, const Unit& u, int wr, int wc, int fr, int fq, LAS unsigned char*) const {
        const long pnoff = pnmode == 1 ? (long)(u.pn >> 2) * 1048576 + (u.pn & 3) * 256 : (long)u.pn * 256;
        bf16_t* base = O + (long)u.pm * pm_stride + pnoff + (long)(wr * 64 + fr) * ldc + wc * 32 + 8 * fq;
#pragma unroll
        for (int ai = 0; ai < 2; ++ai)
#pragma unroll
            for (int m = 0; m < 4; ++m) { bf16_t* rowp = base + (long)(ai * HALF + m * 16) * ldc;
#pragma unroll
                for (int bj = 0; bj < 2; ++bj) { const f32x4 v0 = acc[ai][bj][m][0] * scale, v1 = acc[ai][bj][m][1] * scale;
                    u32x4 w; w.x = pk2(v0[0], v0[1]); w.y = pk2(v0[2], v0[3]); w.z = pk2(v1[0], v1[1]); w.w = pk2(v1[2], v1[3]);
                    *(GAS u32x4*)(rowp + bj * HALF) = w; } }
    }
};
struct EpiVtd {
    static constexpr bool PERM = true;
    bf16_t* O; long rows;
    DI void operator()(const Acc& acc, const Unit& u, int wr, int wc, int fr, int fq, LAS unsigned char*) const {
        bf16_t* base = O + (long)(u.pm * 4 + wr) * rows * 64 + fr * 8 + (long)(u.pn * 32 + wc * 4 + fq) * 512;
#pragma unroll
        for (int ai = 0; ai < 2; ++ai)
#pragma unroll
            for (int m = 0; m < 4; ++m) { bf16_t* rowp = base + (long)ai * 2 * rows * 64 + m * 128;
#pragma unroll
                for (int bj = 0; bj < 2; ++bj) { const f32x4 v0 = acc[ai][bj][m][0], v1 = acc[ai][bj][m][1];
                    u32x4 w; w.x = pk2(v0[0], v0[1]); w.y = pk2(v0[2], v0[3]); w.z = pk2(v1[0], v1[1]); w.w = pk2(v1[2], v1[3]);
                    *(GAS u32x4*)(rowp + bj * 16 * 512) = w; } }
    }
};
DI float dpp_ror1(float x) { return __builtin_bit_cast(float, __builtin_amdgcn_update_dpp(0, __builtin_bit_cast(int, x), 0x121, 0xf, 0xf, false)); }
DI float dpp_rol1(float x) { return __builtin_bit_cast(float, __builtin_amdgcn_update_dpp(0, __builtin_bit_cast(int, x), 0x12F, 0xf, 0xf, false)); }
DI f32x4 ror4(f32x4 v) { return (f32x4){dpp_ror1(v[0]), dpp_ror1(v[1]), dpp_ror1(v[2]), dpp_ror1(v[3])}; }
DI f32x4 rol4(f32x4 v) { return (f32x4){dpp_rol1(v[0]), dpp_rol1(v[1]), dpp_rol1(v[2]), dpp_rol1(v[3])}; }
DI float gelu_t(float x) { const float y = 0.7978845608028654f * (x + 0.044715f * x * x * x); const float e = ex2(2.8853900817779268f * y);
    return x - x * __builtin_amdgcn_rcpf(1.0f + e); }
struct EpiConvGate {
    static constexpr bool PERM = true;
    bf16_t* G; const float* cw; const float* cb; int smask; int chunk_rows;
    DI f32x4 conv1(const Acc& acc, int ai, int bj, int n, int m, int fr, const f32x4& above, const f32x4& below, const f32x4& w0, const f32x4& w1, const f32x4& w2, const f32x4& b, bool zp, bool zn) const {
        const f32x4 cur = acc[ai][bj][m][n];
        const f32x4 tp = (m > 0 && fr == 15) ? acc[ai][bj][m > 0 ? m - 1 : 0][n] : cur;
        const f32x4 tn = (m < 3 && fr == 0) ? acc[ai][bj][m < 3 ? m + 1 : 3][n] : cur;
        f32x4 pv = ror4(tp), nx = rol4(tn);
        if (m == 0 && fr == 0) pv = above;
        if (m == 3 && fr == 15) nx = below;
        if (zp) pv = (f32x4){0.f, 0.f, 0.f, 0.f};
        if (zn) nx = (f32x4){0.f, 0.f, 0.f, 0.f};
        return b + w0 * pv + w1 * cur + w2 * nx;
    }
    DI void operator()(const Acc& acc, const Unit& u, int wr, int wc, int fr, int fq, LAS unsigned char* scr) const {
        LAS float* H = (LAS float*)scr;
        const int colb = wc * 32 + 8 * fq;
        if (fr == 0 || fr == 15) {
#pragma unroll
            for (int ai = 0; ai < 2; ++ai)
#pragma unroll
                for (int bj = 0; bj < 2; ++bj)
#pragma unroll
                    for (int n = 0; n < 2; ++n) {
                        LAS f32x4* dst = (LAS f32x4*)(H + (((2 * ai + wr) * 2 + (fr == 0 ? 0 : 1)) * 256 + bj * HALF + colb + 4 * n));
                        *dst = (fr == 0) ? acc[ai][bj][0][n] : acc[ai][bj][3][n];
                    }
        }
        asm volatile("s_waitcnt lgkmcnt(0)" ::: "memory"); __builtin_amdgcn_s_barrier(); asm volatile("" ::: "memory");
        const int f0 = u.pn * 128 + colb;
        const int row_base = 254 * u.pm - 1;
#pragma unroll
        for (int ai = 0; ai < 2; ++ai) {
            const int k = 2 * ai + wr, ka = k > 0 ? k - 1 : 0, kb = k < 3 ? k + 1 : 3;
#pragma unroll
            for (int n = 0; n < 2; ++n) {
                const float* wp = cw + f0 + 4 * n;
                const f32x4 g0 = *(const f32x4*)wp, g1 = *(const GAS f32x4*)(wp + DFF2), g2 = *(const GAS f32x4*)(wp + 2 * DFF2), gb = *(const GAS f32x4*)(cb + f0 + 4 * n);
                const f32x4 v0 = *(const GAS f32x4*)(wp + DFF), v1 = *(const GAS f32x4*)(wp + DFF + DFF2), v2 = *(const GAS f32x4*)(wp + DFF + 2 * DFF2), vb = *(const GAS f32x4*)(cb + DFF + f0 + 4 * n);
                const f32x4 ag = *(const LAS f32x4*)(H + ((ka * 2 + 1) * 256 + colb + 4 * n)), bg = *(const LAS f32x4*)(H + ((kb * 2 + 0) * 256 + colb + 4 * n));
                const f32x4 av = *(const LAS f32x4*)(H + ((ka * 2 + 1) * 256 + HALF + colb + 4 * n)), bv = *(const LAS f32x4*)(H + ((kb * 2 + 0) * 256 + HALF + colb + 4 * n));
#pragma unroll
                for (int m = 0; m < 4; ++m) {
                    const int tr = ai * HALF + wr * 64 + m * 16 + fr, grow = row_base + tr;
                    const int sm = smask >= 0 ? smask : (grow < TOK_P ? 4095 : 16383);
                    const bool zp = (grow & sm) == 0, zn = ((grow + 1) & sm) == 0;
                    const f32x4 cg = conv1(acc, ai, 0, n, m, fr, ag, bg, g0, g1, g2, gb, zp, zn);
                    const f32x4 cv = conv1(acc, ai, 1, n, m, fr, av, bv, v0, v1, v2, vb, zp, zn);
                    if (tr >= 1 && tr <= 254 && grow >= 0 && grow < chunk_rows) {
                        u32x2 w; w.x = pk2(gelu_t(cg[0]) * cv[0], gelu_t(cg[1]) * cv[1]); w.y = pk2(gelu_t(cg[2]) * cv[2], gelu_t(cg[3]) * cv[3]);
                        *(GAS u32x2*)(G + (size_t)grow * DFF + f0 + 4 * n) = w;
                    }
                }
            }
        }
    }
};
struct EpiF32 {
    static constexpr bool PERM = false;
    float* O; long ldc;
    DI void operator()(const Acc& acc, const Unit& u, int wr, int wc, int fr, int fq, LAS unsigned char*) const {
        float* base = O + ((long)u.pm * 256 + wr * 64 + fr) * ldc + (long)u.pn * 256 + wc * 32 + 4 * fq;
#pragma unroll
        for (int ai = 0; ai < 2; ++ai)
#pragma unroll
            for (int m = 0; m < 4; ++m) { float* rowp = base + (long)(ai * HALF + m * 16) * ldc;
#pragma unroll
                for (int bj = 0; bj < 2; ++bj)
#pragma unroll
                    for (int n = 0; n < 2; ++n) *(GAS f32x4*)(rowp + bj * HALF + n * 16) = acc[ai][bj][m][n]; }
    }
};
struct EpiRope {
    static constexpr bool PERM = true;
    bf16_t* O; const float* cosT; const float* sinT; int smask; float qscale;
    DI void operator()(const Acc& acc, const Unit& u, int wr, int wc, int fr, int fq, LAS unsigned char*) const {
        const int sec = u.pn >> 1; const float sc = (sec == 0 || sec == 2) ? qscale : 1.0f;
#pragma unroll
        for (int ai = 0; ai < 2; ++ai)
#pragma unroll
            for (int m = 0; m < 4; ++m) {
                const int row = u.pm * 256 + ai * HALF + wr * 64 + m * 16 + fr, pos = row & smask;
                const f32x4 c0 = *(const GAS f32x4*)(cosT + pos * 32 + 8 * fq), c1 = *(const GAS f32x4*)(cosT + pos * 32 + 8 * fq + 4);
                const f32x4 s0 = *(const GAS f32x4*)(sinT + pos * 32 + 8 * fq), s1 = *(const GAS f32x4*)(sinT + pos * 32 + 8 * fq + 4);
                const f32x4 x10 = acc[ai][0][m][0], x11 = acc[ai][0][m][1], x20 = acc[ai][1][m][0], x21 = acc[ai][1][m][1];
                const f32x4 a0 = (x10 * c0 - x20 * s0) * sc, a1 = (x11 * c1 - x21 * s1) * sc, b0 = (x20 * c0 + x10 * s0) * sc, b1 = (x21 * c1 + x11 * s1) * sc;
                bf16_t* rowp = O + (long)row * 2048 + u.pn * 256 + wc * 64 + 8 * fq;
                u32x4 w; w.x = pk2(a0[0], a0[1]); w.y = pk2(a0[2], a0[3]); w.z = pk2(a1[0], a1[1]); w.w = pk2(a1[2], a1[3]); *(u32x4*)rowp = w;
                u32x4 v; v.x = pk2(b0[0], b0[1]); v.y = pk2(b0[2], b0[3]); v.z = pk2(b1[0], b1[1]); v.w = pk2(b1[2], b1[3]); *(GAS u32x4*)(rowp + 32) = v;
            }
    }
};
struct EpiSoftmax {
    static constexpr bool PERM = true;
    bf16_t* O; long ldc;
    DI void operator()(Acc& acc, const Unit& u, int wr, int wc, int fr, int fq, LAS unsigned char* scr) const {
        LAS float* red = (LAS float*)scr;
#pragma unroll
        for (int ai = 0; ai < 2; ++ai)
#pragma unroll
            for (int m = 0; m < 4; ++m) { float a = -3.0e38f;
#pragma unroll
                for (int bj = 0; bj < 2; ++bj)
#pragma unroll
                    for (int n = 0; n < 2; ++n) { const f32x4 x = acc[ai][bj][m][n]; a = fmaxf(a, fmaxf(fmaxf(x[0], x[1]), fmaxf(x[2], x[3]))); }
                a = fmaxf(a, shx(a, 16, fq * 16 + fr)); a = fmaxf(a, shx(a, 32, fq * 16 + fr));
                if (fq == 0) red[(ai * HALF + wr * 64 + m * 16 + fr) * 4 + wc] = a; }
        asm volatile("s_waitcnt lgkmcnt(0)" ::: "memory"); __builtin_amdgcn_s_barrier(); asm volatile("" ::: "memory");
#pragma unroll
        for (int ai = 0; ai < 2; ++ai)
#pragma unroll
            for (int m = 0; m < 4; ++m) { const f32x4 t = *(const LAS f32x4*)(red + (ai * HALF + wr * 64 + m * 16 + fr) * 4);
                const float M = fmaxf(fmaxf(t[0], t[1]), fmaxf(t[2], t[3])); float s = 0.f;
#pragma unroll
                for (int bj = 0; bj < 2; ++bj)
#pragma unroll
                    for (int n = 0; n < 2; ++n) { f32x4 x = acc[ai][bj][m][n]; x[0] = ex2(x[0] - M); x[1] = ex2(x[1] - M); x[2] = ex2(x[2] - M); x[3] = ex2(x[3] - M); acc[ai][bj][m][n] = x; s += (x[0] + x[1]) + (x[2] + x[3]); }
                s += shx(s, 16, fq * 16 + fr); s += shx(s, 32, fq * 16 + fr);
                if (fq == 0) red[1024 + (ai * HALF + wr * 64 + m * 16 + fr) * 4 + wc] = s; }
        asm volatile("s_waitcnt lgkmcnt(0)" ::: "memory"); __builtin_amdgcn_s_barrier(); asm volatile("" ::: "memory");
        bf16_t* base = O + ((long)u.pm * 256 + wr * 64 + fr) * ldc + (long)u.pn * 256 + wc * 32 + 8 * fq;
#pragma unroll
        for (int ai = 0; ai < 2; ++ai)
#pragma unroll
            for (int m = 0; m < 4; ++m) { const f32x4 t = *(const LAS f32x4*)(red + 1024 + (ai * HALF + wr * 64 + m * 16 + fr) * 4);
                const float inv = __builtin_amdgcn_rcpf((t[0] + t[1]) + (t[2] + t[3])); bf16_t* rowp = base + (long)(ai * HALF + m * 16) * ldc;
#pragma unroll
                for (int bj = 0; bj < 2; ++bj) { const f32x4 v0 = acc[ai][bj][m][0] * inv, v1 = acc[ai][bj][m][1] * inv;
                    u32x4 w; w.x = pk2(v0[0], v0[1]); w.y = pk2(v0[2], v0[3]); w.z = pk2(v1[0], v1[1]); w.w = pk2(v1[2], v1[3]);
                    *(GAS u32x4*)(rowp + bj * HALF) = w; } }
        asm volatile("s_waitcnt lgkmcnt(0)" ::: "memory");
    }
};

template <class Epi>
DI void gemm_phase(int wv, LAS unsigned char* lds, LAS unsigned char* scr, const Sched& S, const Epi& E) {
    const int tid = get_tid(wv);
    const int wid = __builtin_amdgcn_readfirstlane(tid >> 6), lane = tid & 63, wr = wid >> 2, wc = wid & 3, fr = lane & 15, fq = lane >> 4;
    const int K = S.K, nt = K / BK;
    unsigned voffA[2], voffB[2];
#pragma unroll
    for (int i = 0; i < 2; ++i) { int R, C; stage_rc(tid * 16 + i * 8192, R, C); const int Rb = Epi::PERM ? ((R & ~31) + perm32(R & 31)) : R;
        voffA[i] = (unsigned)(R * S.lda + C) * 2u; voffB[i] = (unsigned)(Rb * S.ldb + C) * 2u; }
    const size_t kstep = (size_t)(BK * 2);
    const size_t hstepA = (size_t)HALF * S.lda * 2, hstepB = (size_t)HALF * S.ldb * 2;
    const unsigned ldsw = (unsigned)wid * 1024u;
    const int aoff = lds_byte(wr * 64 + fr, fq * 8), boff = lds_byte(wc * 32 + fr, fq * 8);
#define PG8_SA(b, h) (((b) * 2 + (h)) * HTB)
#define PG8_SB(b, h) ((4 + (b) * 2 + (h)) * HTB)
#define PG8_STAGE(bufoff, gbase, voff) do { _Pragma("unroll") for (int _i = 0; _i < 2; ++_i) \
        __builtin_amdgcn_global_load_lds((const unsigned*)((const char*)(gbase) + (voff)[_i]), (LAS unsigned*)(lds + (bufoff) + ldsw + _i * 8192), 16, 0, 0); } while (0)
#define PG8_LDA(dst, b, h) do { _Pragma("unroll") for (int m = 0; m < 4; ++m) _Pragma("unroll") for (int k = 0; k < 2; ++k) dst[m][k] = *(const LAS bf16x8*)(lds + PG8_SA(b, h) + aoff + m * 2048 + k * 1024); } while (0)
#define PG8_LDB(dst, b, h) do { _Pragma("unroll") for (int n = 0; n < 2; ++n) _Pragma("unroll") for (int k = 0; k < 2; ++k) dst[n][k] = *(const LAS bf16x8*)(lds + PG8_SB(b, h) + boff + n * 2048 + k * 1024); } while (0)
#define PG8_MMA(ai, bj, At, Bt) do { __builtin_amdgcn_s_setprio(1); _Pragma("unroll") for (int m = 0; m < 4; ++m) _Pragma("unroll") for (int n = 0; n < 2; ++n) _Pragma("unroll") for (int k = 0; k < 2; ++k) \
        acc[ai][bj][m][n] = __builtin_amdgcn_mfma_f32_16x16x32_bf16(Bt[n][k], At[m][k], acc[ai][bj][m][n], 0, 0, 0); __builtin_amdgcn_s_setprio(0); } while (0)
#define PG8_WAIT_V(n) asm volatile("s_waitcnt vmcnt(" #n ")" ::: "memory")
#define PG8_WAIT_L(n) asm volatile("s_waitcnt lgkmcnt(" #n ")" ::: "memory")
#define PG8_BAR __builtin_amdgcn_s_barrier()
#define PG8_SCHED __builtin_amdgcn_sched_barrier(0)
    Unit cur, nxt; int ui = 0;
    if (!S.next(0, cur)) return;
    Acc acc;
#pragma unroll
    for (int a = 0; a < 2; ++a)
#pragma unroll
        for (int b = 0; b < 2; ++b)
#pragma unroll
            for (int m = 0; m < 4; ++m)
#pragma unroll
                for (int n = 0; n < 2; ++n) acc[a][b][m][n] = (f32x4){0.f, 0.f, 0.f, 0.f};
    bf16x8 At[4][2], B0[2][2], B1[2][2];
    const char* cA = S.baseA(cur); const char* cB = S.baseB(cur);
    PG8_STAGE(PG8_SB(0, 0), cB, voffB); PG8_STAGE(PG8_SB(0, 1), cB + hstepB, voffB); PG8_STAGE(PG8_SA(0, 0), cA, voffA); PG8_STAGE(PG8_SA(0, 1), cA + hstepA, voffA);
    if (wr == 1) PG8_BAR;
    PG8_WAIT_V(2); PG8_BAR;
    PG8_STAGE(PG8_SB(1, 0), cB + kstep, voffB); PG8_STAGE(PG8_SA(1, 0), cA + kstep, voffA); PG8_STAGE(PG8_SB(1, 1), cB + hstepB + kstep, voffB);
    PG8_WAIT_V(6); PG8_BAR;
    for (;;) {
        const bool has_next = S.next(ui + 1, nxt);
        const char* nA = has_next ? S.baseA(nxt) : cA; const char* nB = has_next ? S.baseB(nxt) : cB;
        for (int t = 0; t < nt; t += 2) {
            const bool last = (t == nt - 2);
            const char* a1 = cA + (size_t)(t + 1) * kstep;
            const char* a2 = last ? nA : cA + (size_t)(t + 2) * kstep; const char* b2 = last ? nB : cB + (size_t)(t + 2) * kstep;
            const char* a3 = a2 + kstep; const char* b3 = b2 + kstep;
            PG8_LDB(B0, 0, 0); PG8_LDB(B1, 0, 1); PG8_SCHED; PG8_LDA(At, 0, 0); PG8_STAGE(PG8_SA(1, 1), a1 + hstepA, voffA);
            PG8_WAIT_V(8); PG8_WAIT_L(0); PG8_BAR; PG8_MMA(0, 0, At, B0); PG8_MMA(0, 1, At, B1); PG8_BAR; PG8_SCHED;
            PG8_LDA(At, 0, 1); PG8_STAGE(PG8_SB(0, 0), b2, voffB); PG8_STAGE(PG8_SB(0, 1), b2 + hstepB, voffB); PG8_STAGE(PG8_SA(0, 0), a2, voffA);
            PG8_WAIT_V(8); PG8_WAIT_L(0); PG8_BAR; PG8_MMA(1, 0, At, B0); PG8_MMA(1, 1, At, B1); PG8_BAR; PG8_SCHED;
            PG8_LDB(B0, 1, 0); PG8_LDB(B1, 1, 1); PG8_SCHED; PG8_LDA(At, 1, 0); PG8_STAGE(PG8_SA(0, 1), a2 + hstepA, voffA);
            PG8_WAIT_V(8); PG8_WAIT_L(0); PG8_BAR; PG8_MMA(0, 0, At, B0); PG8_MMA(0, 1, At, B1); PG8_BAR; PG8_SCHED;
            PG8_LDA(At, 1, 1); PG8_STAGE(PG8_SB(1, 0), b3, voffB); PG8_STAGE(PG8_SB(1, 1), b3 + hstepB, voffB); PG8_STAGE(PG8_SA(1, 0), a3, voffA);
            PG8_WAIT_V(8); PG8_WAIT_L(0); PG8_BAR; PG8_MMA(1, 0, At, B0); PG8_MMA(1, 1, At, B1); PG8_BAR; PG8_SCHED;
        }
        if (wr == 0) PG8_BAR;
        E(acc, cur, wr, wc, fr, fq, scr);
        if (!has_next) break;
#pragma unroll
        for (int a = 0; a < 2; ++a)
#pragma unroll
            for (int b = 0; b < 2; ++b)
#pragma unroll
                for (int m = 0; m < 4; ++m)
#pragma unroll
                    for (int n = 0; n < 2; ++n) acc[a][b][m][n] = (f32x4){0.f, 0.f, 0.f, 0.f};
        cur = nxt; cA = nA; cB = nB; ++ui;
        if (wr == 1) PG8_BAR;
    }
    PG8_WAIT_V(0);
    PG8_BAR;
#undef PG8_SA
#undef PG8_SB
#undef PG8_STAGE
#undef PG8_LDA
#undef PG8_LDB
#undef PG8_MMA
#undef PG8_WAIT_V
#undef PG8_WAIT_L
#undef PG8_BAR
#undef PG8_SCHED
}
}

template <class DR>
DI void transpose_item(const float* W, int ldw, int kb, int n0, bf16_t* WT, int Kd, LAS float* scr, int lane, const DR& drow) {
    const int k0 = 64 * kb;
#pragma unroll 8
    for (int i = 0; i < 32; ++i) { const int kk = 2 * i + (lane >> 5); scr[kk * 33 + (lane & 31)] = ((const GAS float*)W)[(size_t)(k0 + kk) * ldw + n0 + (lane & 31)]; }
    asm volatile("s_waitcnt lgkmcnt(0)" ::: "memory");
    const int c = lane & 7;
#pragma unroll
    for (int j = 0; j < 4; ++j) { const int n = (lane >> 3) + 8 * j; const LAS float* s = scr + (8 * c) * 33 + n;
        u32x4 o; o.x = pk2(s[0 * 33], s[1 * 33]); o.y = pk2(s[2 * 33], s[3 * 33]); o.z = pk2(s[4 * 33], s[5 * 33]); o.w = pk2(s[6 * 33], s[7 * 33]);
        *(GAS u32x4*)(WT + (size_t)drow(n0 + n) * Kd + k0 + 8 * c) = o; }
    asm volatile("s_waitcnt lgkmcnt(0)" ::: "memory");
}
struct DrowId { int off; DI int operator()(int n) const { return n + off; } };
struct DrowUp { DI int operator()(int s) const { const int isv = s >= DFF ? 1 : 0, f = s - isv * DFF; return (f >> 7) * 256 + isv * 128 + (f & 127); } };
struct DrowWin { DI int operator()(int s) const {
    const int sec = s >> 9, within = s & 511;
    if (sec == 2) return 2048 + within;
    if (sec == 5) return 2048 + 512 + within;
    const int dsec = sec < 2 ? sec : sec - 1; const int lc = dsec * 512 + within;
    return (lc & ~255) + ((lc >> 6) & 3) * 32 + (lc & 31) + 128 * ((lc >> 5) & 1); } };

DI void norm_row_bf16(const f32x4 (&v)[4], const float* g, bf16_t* orow, int lane) {
    float s = 0.f;
#pragma unroll
    for (int j = 0; j < 4; ++j) s += (v[j].x * v[j].x + v[j].y * v[j].y) + (v[j].z * v[j].z + v[j].w * v[j].w);
    const float rstd = __builtin_amdgcn_rsqf(wave_sum(s, lane) * (1.0f / DM) + RMS_EPS);
    GAS u32x2* o8 = (GAS u32x2*)orow + lane;
#pragma unroll
    for (int j = 0; j < 4; ++j) { const f32x4 gg = ((const GAS f32x4*)g)[lane + 64 * j]; u32x2 w; w.x = pk2(v[j].x * rstd * gg.x, v[j].y * rstd * gg.y); w.y = pk2(v[j].z * rstd * gg.z, v[j].w * rstd * gg.w); o8[64 * j] = w; }
}

DI void post_pass(int wv, const bf16_t* raw, long raw_row0, float* x, const float* gpost, const float* gpre, bf16_t* XN, int row_lo, int row_hi, const float* xin_p = nullptr, const float* xin_s = nullptr) {
    const int tid = get_tid(wv);
    const int lane = tid & 63, gw = blockIdx.x * 8 + __builtin_amdgcn_readfirstlane(tid >> 6), NGW = gridDim.x * 8;
    for (int row = row_lo + gw; row < row_hi; row += 2 * NGW) {
        f32x4 v[2][4], xv[2][4]; float s[2] = {0.f, 0.f};
#pragma unroll
        for (int q = 0; q < 2; ++q) { const int rw = row + q * NGW;
            const GAS u32x2* rr = (const GAS u32x2*)(raw + (size_t)(rw - raw_row0) * DM) + lane;
            const GAS f32x4* xr = (const GAS f32x4*)(xin_p ? (rw < TOK_P ? xin_p + (size_t)rw * DM : xin_s + (size_t)(rw - TOK_P) * DM) : x + (size_t)rw * DM) + lane;
#pragma unroll
            for (int j = 0; j < 4; ++j) { const u32x2 w = rr[64 * j]; v[q][j] = (f32x4){bf_lo(w.x), bf_hi(w.x), bf_lo(w.y), bf_hi(w.y)}; xv[q][j] = xr[64 * j]; } }
#pragma unroll
        for (int q = 0; q < 2; ++q)
#pragma unroll
            for (int j = 0; j < 4; ++j) s[q] += (v[q][j].x * v[q][j].x + v[q][j].y * v[q][j].y) + (v[q][j].z * v[q][j].z + v[q][j].w * v[q][j].w);
#pragma unroll
        for (int q = 0; q < 2; ++q) { const int rw = row + q * NGW; GAS f32x4* xr = (GAS f32x4*)(x + (size_t)rw * DM) + lane;
            const float rstd = __builtin_amdgcn_rsqf(wave_sum(s[q], lane) * (1.0f / DM) + RMS_EPS);
#pragma unroll
            for (int j = 0; j < 4; ++j) { const f32x4 gg = ((const GAS f32x4*)gpost)[lane + 64 * j]; xv[q][j] = xv[q][j] + v[q][j] * rstd * gg; xr[64 * j] = xv[q][j]; }
            if (gpre) norm_row_bf16(xv[q], gpre, XN + (size_t)rw * DM, lane); }
    }
}

DI float gelu_tanh(float x) { const float y = 0.7978845608028654f * (x + 0.044715f * x * x * x); const float e = __expf(2.0f * y); const float t = 1.0f - 2.0f / (1.0f + e); return 0.5f * x * (1.0f + t); }

DI void convgate_pass(int wv, const bf16_t* U, bf16_t* Gt, int rows, int smask, const float* cw, const float* cb) {
    const int tid = get_tid(wv);
    const long nitems = (long)(rows / 16) * 352; const long gt = (long)blockIdx.x * 512 + tid, ngt = (long)gridDim.x * 512;
    for (long it = gt; it < nitems; it += ngt) {
        const int cg8 = (int)(it % 352), rb = (int)(it / 352), j0 = cg8 * 8, r0 = rb * 16;
        float wg[3][8], wv[3][8], bg[8], bv[8];
#pragma unroll
        for (int t = 0; t < 3; ++t)
#pragma unroll
            for (int i = 0; i < 8; ++i) { wg[t][i] = cw[t * DFF2 + j0 + i]; wv[t][i] = cw[t * DFF2 + DFF + j0 + i]; }
#pragma unroll
        for (int i = 0; i < 8; ++i) { bg[i] = cb[j0 + i]; bv[i] = cb[DFF + j0 + i]; }
        const u32x4 zero = {0u, 0u, 0u, 0u};
        u32x4 gp, gc, gn, vp, vc, vn;
        const bf16_t* base = U + (size_t)r0 * DFF2 + j0;
        if ((r0 & smask) == 0) { gp = zero; vp = zero; } else { gp = *(const GAS u32x4*)(base - DFF2); vp = *(const GAS u32x4*)(base - DFF2 + DFF); }
        gc = *(const u32x4*)base; vc = *(const GAS u32x4*)(base + DFF);
#pragma unroll
        for (int r = 0; r < 16; ++r) {
            const int row = r0 + r;
            if (((row + 1) & smask) == 0) { gn = zero; vn = zero; } else { gn = *(const GAS u32x4*)(base + (size_t)(r + 1) * DFF2); vn = *(const GAS u32x4*)(base + (size_t)(r + 1) * DFF2 + DFF); }
            u32x4 o;
#pragma unroll
            for (int q = 0; q < 4; ++q) {
                const float g0 = bg[2 * q] + bf_lo(gp[q]) * wg[0][2 * q] + bf_lo(gc[q]) * wg[1][2 * q] + bf_lo(gn[q]) * wg[2][2 * q];
                const float g1 = bg[2 * q + 1] + bf_hi(gp[q]) * wg[0][2 * q + 1] + bf_hi(gc[q]) * wg[1][2 * q + 1] + bf_hi(gn[q]) * wg[2][2 * q + 1];
                const float v0 = bv[2 * q] + bf_lo(vp[q]) * wv[0][2 * q] + bf_lo(vc[q]) * wv[1][2 * q] + bf_lo(vn[q]) * wv[2][2 * q];
                const float v1 = bv[2 * q + 1] + bf_hi(vp[q]) * wv[0][2 * q + 1] + bf_hi(vc[q]) * wv[1][2 * q + 1] + bf_hi(vn[q]) * wv[2][2 * q + 1];
                o[q] = pk2(gelu_tanh(g0) * v0, gelu_tanh(g1) * v1);
            }
            *(GAS u32x4*)(Gt + (size_t)row * DFF + j0) = o;
            gp = gc; gc = gn; vp = vc; vc = vn;
        }
    }
}

#define GLDS16(gp, ldst) __builtin_amdgcn_global_load_lds((const unsigned*)(gp), (LAS unsigned*)(ldst), 16, 0, 0)
DI void glds16_s(const void* sbase, unsigned voff, unsigned ldsaddr) {
    unsigned keep;
    asm volatile("s_mov_b32 %0, m0\n\ts_mov_b32 m0, %3\n\ts_nop 0\n\tglobal_load_lds_dwordx4 %1, %2\n\ts_mov_b32 m0, %0" : "=&s"(keep) : "v"(voff), "s"(sbase), "s"(ldsaddr) : "memory");
}
DI void attn_step32(f32x16& sc, f32x16& sn, f32x16 (&O)[4], const f32x16& negm, float& lsum, float& mrun, const bf16x8 (&qf)[4],
                    bf16x8 (&kf)[4], const LAS unsigned char* kb_next, bool has_next, const LAS unsigned char* vb, const int (&ko)[4], int vo0, int vo1) {
    bf16x8 vf[8];
#pragma unroll
    for (int cb = 0; cb < 4; ++cb) { vf[cb] = *(const LAS bf16x8*)(vb + vo0 + cb * 4096); vf[4 + cb] = *(const LAS bf16x8*)(vb + vo1 + cb * 4096); }
    __builtin_amdgcn_sched_barrier(0);
    sn = negm;
#pragma unroll
    for (int ds = 0; ds < 4; ++ds) sn = MFMA32(kf[ds], qf[ds], sn);
    if (has_next) {
#pragma unroll
        for (int ds = 0; ds < 4; ++ds) kf[ds] = *(const LAS bf16x8*)(kb_next + ko[ds]);
    }
    __builtin_amdgcn_sched_barrier(0);
    float mx = max3f(sc[0], sc[1], sc[2]), my = max3f(sc[3], sc[4], sc[5]);
    mx = max3f(mx, sc[6], sc[7]); my = max3f(my, sc[8], sc[9]); mx = max3f(mx, sc[10], sc[11]); my = max3f(my, sc[12], sc[13]); mx = max3f(mx, sc[14], sc[15]);
    mrun = max3f(mrun, mx, my);
    float ps = 0.f;
#pragma unroll
    for (int i = 0; i < 16; ++i) { sc[i] = ex2(sc[i]); ps += sc[i]; }
    lsum += ps;
    u32x4 w0, w1;
    w0.x = pk2(sc[0], sc[1]); w0.y = pk2(sc[2], sc[3]); w0.z = pk2(sc[4], sc[5]); w0.w = pk2(sc[6], sc[7]);
    w1.x = pk2(sc[8], sc[9]); w1.y = pk2(sc[10], sc[11]); w1.z = pk2(sc[12], sc[13]); w1.w = pk2(sc[14], sc[15]);
    const bf16x8 pf0 = __builtin_bit_cast(bf16x8, w0), pf1 = __builtin_bit_cast(bf16x8, w1);
#pragma unroll
    for (int cb = 0; cb < 4; ++cb) O[cb] = MFMA32(vf[cb], pf0, O[cb]);
#pragma unroll
    for (int cb = 0; cb < 4; ++cb) O[cb] = MFMA32(vf[4 + cb], pf1, O[cb]);
}
DI void attn_renorm(f32x16& spend, f32x16 (&O)[4], f32x16& negm, float& mref, float& lsum, float& mrun) {
    constexpr float THR = 6.0f;
    const float mx = swap_max(mrun);
    if (__any(mx > THR)) {
        const float dl = fmaxf(mx, 0.f), alpha = ex2(-dl);
        mref += dl; lsum *= alpha;
#pragma unroll
        for (int cb = 0; cb < 4; ++cb) O[cb] = O[cb] * alpha;
#pragma unroll
        for (int i = 0; i < 16; ++i) { spend[i] -= dl; negm[i] = -mref; }
    }
    mrun = -1.0e30f;
}

DI void diff_attn_phase(int wv, LAS unsigned char* lds, const bf16_t* QK, const bf16_t* VT, int rows, int nb, int S, bf16_t* OUT, const float* lq1, const float* lk1, const float* lq2, const float* lk2, float lam0, float lam1, int layer, const float* gsub) {
    const int tid = get_tid(wv);
    asm volatile("" : "+s"(layer));
    float lam_i = layer == 0 ? lam0 : lam1;
    const int lane = tid & 63, r = lane & 31, hi = lane >> 5, wid = __builtin_amdgcn_readfirstlane(tid >> 6), map = wid >> 2, qsub = wid & 3;
    lam_i = __uint_as_float(__builtin_amdgcn_readfirstlane(__float_as_uint(lam_i)));
    constexpr int KBYTES = 16384, STG = 32768;
    const int nqb = S / 128, nunits = nb * 4 * nqb, NT = S / 64;
    const int pr = (r & 0x13) | ((r & 4) << 1) | ((r & 8) >> 1);
    int ko[4], vo[4];
#pragma unroll
    for (int i = 0; i < 4; ++i) { ko[i] = pr * 256 + (((map * 8 + 2 * i + hi) ^ (pr & 15)) << 4); vo[i] = r * 128 + (((2 * i + hi) ^ ((r >> 1) & 7)) << 4); }
    unsigned kofs[2], vofs[2];
#pragma unroll
    for (int i = 0; i < 2; ++i) { const int L = wid * 1024 + i * 8192 + lane * 16;
        const int kr_ = L >> 8, kc_ = ((L >> 4) & 15) ^ (kr_ & 15); kofs[i] = (unsigned)(kr_ * 4096 + kc_ * 16);
        const int vr_ = L >> 7, vc_ = ((L >> 4) & 7) ^ ((vr_ >> 1) & 7); vofs[i] = (unsigned)vr_ * (unsigned)rows * 2u + (unsigned)(vc_ * 16); }
    const unsigned dml = wid * 1024;
    const int upx = nunits >> 3, xcd = blockIdx.x & 7, xj = blockIdx.x >> 3, xstride = gridDim.x >> 3;
    for (int k = xj; k < upx; k += xstride) {
        const int u = xcd * upx + k;
        const int qb = u & (nqb - 1), bh = u >> __builtin_ctz(nqb), h = bh & 3, b = bh >> 2;
        const size_t seq0 = (size_t)b * S;
        bf16x8 qf[4];
        { const int ln = get_tid(wv) & 63;
          const bf16_t* qp = QK + (seq0 + qb * 128 + qsub * 32 + (ln & 31)) * 2048 + (2 * h + map) * 64 + 8 * (ln >> 5);
#pragma unroll
          for (int ds = 0; ds < 4; ++ds) qf[ds] = *(const GAS bf16x8*)(qp + 16 * ds); }
        const char* kbase = (const char*)(QK + seq0 * 2048 + 512 + 128 * h);
        const char* vbase = (const char*)(VT + (size_t)(128 * h) * rows + seq0);
#define KS(j) (lds + (j) * 16384)
#define VS(j) (lds + 65536 + (j) * 16384)
#define CLT(t) ((t) < NT ? (t) : NT - 1)
#define DMA_KH(t, hf) do { const int t_ = CLT(t); glds16_s(kbase + (size_t)t_ * (64 * 4096), kofs[hf], (unsigned)(size_t)(KS((t) & 3) + dml + (hf) * 8192)); } while (0)
#define DMA_V(t) do { const char* b_ = vbase + (size_t)CLT(t) * 128; _Pragma("unroll") for (int i_ = 0; i_ < 2; ++i_) glds16_s(b_, vofs[i_], (unsigned)(size_t)(VS((t) & 3) + dml + i_ * 8192)); } while (0)
        f32x16 O[4];
#pragma unroll
        for (int cb = 0; cb < 4; ++cb)
#pragma unroll
            for (int i = 0; i < 16; ++i) O[cb][i] = 0.f;
        DMA_KH(0, 0); DMA_KH(0, 1); DMA_V(0); DMA_KH(1, 0); DMA_KH(1, 1); DMA_KH(2, 0); DMA_V(1);
        asm volatile("s_waitcnt vmcnt(0)" ::: "memory"); __syncthreads();
        f32x16 sa, sb, negm;
#pragma unroll
        for (int i = 0; i < 16; ++i) sa[i] = 0.f;
#pragma unroll
        for (int ds = 0; ds < 4; ++ds) sa = MFMA32(*(const LAS bf16x8*)(lds + ko[ds]), qf[ds], sa);
        float mref, lsum = 0.f, mrun = -1.0e30f;
        { float mx = fmaxf(sa[0], sa[1]);
#pragma unroll
          for (int i = 2; i < 16; ++i) mx = fmaxf(mx, sa[i]);
          mref = swap_max(mx);
#pragma unroll
          for (int i = 0; i < 16; ++i) { sa[i] -= mref; negm[i] = -mref; } }
        __syncthreads();
        for (int a = 0; a < NT; a += 4) {
            DMA_KH(a + 2, 1); DMA_KH(a + 3, 0); DMA_KH(a + 3, 1); DMA_KH(a + 4, 0); DMA_V(a + 2); DMA_V(a + 3);
            bf16x8 kf[4];
#pragma unroll
            for (int ds = 0; ds < 4; ++ds) kf[ds] = *(const LAS bf16x8*)(KS(0) + 8192 + ko[ds]);
            attn_step32(sa, sb, O, negm, lsum, mrun, qf, kf, KS(1), true, VS(0), ko, vo[0], vo[1]);
            attn_step32(sb, sa, O, negm, lsum, mrun, qf, kf, KS(1) + 8192, true, VS(0), ko, vo[2], vo[3]);
            attn_step32(sa, sb, O, negm, lsum, mrun, qf, kf, KS(2), true, VS(1), ko, vo[0], vo[1]);
            attn_step32(sb, sa, O, negm, lsum, mrun, qf, kf, KS(0), false, VS(1), ko, vo[2], vo[3]);
            attn_renorm(sa, O, negm, mref, lsum, mrun);
            asm volatile("s_waitcnt vmcnt(0)" ::: "memory"); __syncthreads();
            DMA_KH(a + 4, 1); DMA_KH(a + 5, 0); DMA_KH(a + 5, 1); DMA_KH(a + 6, 0); DMA_V(a + 4); DMA_V(a + 5);
#pragma unroll
            for (int ds = 0; ds < 4; ++ds) kf[ds] = *(const LAS bf16x8*)(KS(2) + 8192 + ko[ds]);
            attn_step32(sa, sb, O, negm, lsum, mrun, qf, kf, KS(3), true, VS(2), ko, vo[0], vo[1]);
            attn_step32(sb, sa, O, negm, lsum, mrun, qf, kf, KS(3) + 8192, true, VS(2), ko, vo[2], vo[3]);
            attn_step32(sa, sb, O, negm, lsum, mrun, qf, kf, KS(0), true, VS(3), ko, vo[0], vo[1]);
            attn_step32(sb, sa, O, negm, lsum, mrun, qf, kf, KS(0), false, VS(3), ko, vo[2], vo[3]);
            attn_renorm(sa, O, negm, mref, lsum, mrun);
            asm volatile("s_waitcnt vmcnt(0)" ::: "memory"); __syncthreads();
        }
#undef DMA_KH
#undef DMA_V
#undef KS
#undef VS
#undef CLT
        lsum = swap_sum(lsum);
        const float inv = __builtin_amdgcn_rcpf(lsum);
        LAS float* X = (LAS float*)lds;
        if (map == 1) {
            const int lane = get_tid(wv) & 63;
#pragma unroll
            for (int cb = 0; cb < 4; ++cb)
#pragma unroll
                for (int i = 0; i < 16; ++i) X[((qsub * 4 + cb) * 16 + i) * 64 + lane] = O[cb][i] * inv;
        }
        __syncthreads();
        if (map == 0) {
            const int lane = get_tid(wv) & 63, r = lane & 31, hi = lane >> 5;
            float li = lam_i; asm volatile("" : "+s"(li));
            const float lam = __expf(wave_sum(lq1[lane] * lk1[lane], lane)) - __expf(wave_sum(lq2[lane] * lk2[lane], lane)) + li;
            const float oml = 1.0f - li;
            float ss = 0.f;
#pragma unroll
            for (int cb = 0; cb < 4; ++cb)
#pragma unroll
                for (int i = 0; i < 16; ++i) { const float d = O[cb][i] * inv - lam * X[((qsub * 4 + cb) * 16 + i) * 64 + lane]; O[cb][i] = d; ss += d * d; }
            ss = swap_sum(ss);
            const float rstd = oml * __builtin_amdgcn_rsqf(ss * (1.0f / 128.0f) + RMS_EPS);
            bf16_t* orow = OUT + (seq0 + qb * 128 + qsub * 32 + r) * 1024 + h * 128 + 4 * hi;
#pragma unroll
            for (int cb = 0; cb < 4; ++cb)
#pragma unroll
                for (int j4 = 0; j4 < 4; ++j4) { const f32x4 gg = *(const GAS f32x4*)(gsub + 32 * cb + 8 * j4 + 4 * hi);
                    u32x2 w; w.x = pk2(O[cb][4 * j4] * rstd * gg.x, O[cb][4 * j4 + 1] * rstd * gg.y); w.y = pk2(O[cb][4 * j4 + 2] * rstd * gg.z, O[cb][4 * j4 + 3] * rstd * gg.w);
                    *(GAS u32x2*)(orow + 32 * cb + 8 * j4) = w; }
        }
        __syncthreads();
    }
}

DI void dil_phase(int wv, const bf16_t* QK, const bf16_t* VTg, int rows, int nb, int S, int rr, int pat, bf16_t* OUT, float* LSE) {
    const int tid = get_tid(wv);
    const int lane = tid & 63, r = lane & 31, hi = lane >> 5, wid = __builtin_amdgcn_readfirstlane(tid >> 6);
    const int pr = (r & 0x13) | ((r & 4) << 1) | ((r & 8) >> 1);
    const int Sr = S >> __builtin_ctz(rr), ublk = Sr / 32, per_sh = S / 32, nunits = nb * 8 * per_sh;
    const int upx = nunits >> 3, xcd = blockIdx.x & 7, lw = (blockIdx.x >> 3) * 8 + wid, lstride = (gridDim.x >> 3) * 8;
    for (int k = lw; k < upx; k += lstride) {
        const int wu = xcd * upx + k;
        const int inner = wu & (per_sh - 1), sh = wu >> __builtin_ctz(per_sh), head = sh & 7, seq = sh >> 3;
        const int cls = inner >> __builtin_ctz(ublk), i0 = (inner & (ublk - 1)) * 32;
        const size_t seq0 = (size_t)seq * S;
        const int qtok = cls + rr * (i0 + r);
        const bf16_t* qp = QK + (seq0 + qtok) * 2048 + 1024 + head * 64 + 8 * hi;
        const bf16_t* kbase = QK + (seq0 + cls) * 2048 + 1536 + head * 64 + 8 * hi;
        const bf16_t* vbase = VTg + (size_t)head * rows * 64 + ((seq0 + (size_t)cls * Sr) >> 3) * 512 + r * 8;
        bf16_t* orow = OUT + (seq0 + qtok) * 1024 + 512 + head * 64 + 4 * hi;
        GAS float* lsep = (GAS float*)(LSE + (seq0 + qtok) * 8 + head);
        bf16x8 qf[4];
#pragma unroll
        for (int ds = 0; ds < 4; ++ds) qf[ds] = *(const GAS bf16x8*)(qp + 16 * ds);
        bf16x8 kf[4], vf[4], kn[4], vn[4];
#define DIL_LOAD(KF, VF, kb) do { int mk_ = i0 - 64 + 32 * (kb) + pr; mk_ = mk_ < 0 ? 0 : (mk_ >= Sr ? Sr - 1 : mk_); const bf16_t* kp_ = kbase + (size_t)rr * mk_ * 2048; \
            _Pragma("unroll") for (int ds_ = 0; ds_ < 4; ++ds_) KF[ds_] = *(const GAS bf16x8*)(kp_ + 16 * ds_); \
            _Pragma("unroll") for (int s8_ = 0; s8_ < 2; ++s8_) { int m0_ = i0 - 64 + 16 * (2 * (kb) + s8_) + 8 * hi; m0_ = (m0_ < 0 || m0_ >= Sr) ? 0 : m0_; \
                _Pragma("unroll") for (int cb_ = 0; cb_ < 2; ++cb_) VF[s8_ * 2 + cb_] = *(const GAS bf16x8*)(vbase + (size_t)(m0_ >> 3) * 512 + cb_ * 256); } } while (0)
        const int klo = max(64 - i0, r) - 8 * hi, khi = min(Sr - 1 + 64 - i0, r + 128) - 8 * hi;
        DIL_LOAD(kf, vf, 0);
        f32x16 O[2]; float mrun, lrun;
        if (pat > 0) {
            mrun = *lsep; lrun = hi == 0 ? 1.0f : 0.0f;
#pragma unroll
            for (int cb = 0; cb < 2; ++cb)
#pragma unroll
                for (int j4 = 0; j4 < 4; ++j4) { const u32x2 w = *(const GAS u32x2*)(orow + 32 * cb + 8 * j4);
                    O[cb][4 * j4] = bf_lo(w.x); O[cb][4 * j4 + 1] = bf_hi(w.x); O[cb][4 * j4 + 2] = bf_lo(w.y); O[cb][4 * j4 + 3] = bf_hi(w.y); }
        } else {
            mrun = -1.0e30f; lrun = 0.f;
#pragma unroll
            for (int cb = 0; cb < 2; ++cb)
#pragma unroll
                for (int i = 0; i < 16; ++i) O[cb][i] = 0.f;
        }
#pragma unroll
        for (int kb = 0; kb < 5; ++kb) {
            if (kb < 4) DIL_LOAD(kn, vn, kb + 1);
            f32x16 sc;
#pragma unroll
            for (int i = 0; i < 16; ++i) sc[i] = 0.f;
#pragma unroll
            for (int ds = 0; ds < 4; ++ds) sc = MFMA32(kf[ds], qf[ds], sc);
            float mx = -3.0e38f;
#pragma unroll
            for (int i = 0; i < 16; ++i) {
                const int kc = 32 * kb + 16 * (i >> 3) + (i & 7);
                const bool ok = (kc >= klo) && (kc <= khi);
                const float v = ok ? sc[i] : -INFINITY; sc[i] = v; mx = fmaxf(mx, v);
            }
            mx = swap_max(mx);
            const float mnew = fmaxf(mrun, mx), alpha = ex2(mrun - mnew);
            float ps = 0.f;
#pragma unroll
            for (int i = 0; i < 16; ++i) { const float p = ex2(sc[i] - mnew); sc[i] = p; ps += p; }
            lrun = lrun * alpha + ps; mrun = mnew;
#pragma unroll
            for (int cb = 0; cb < 2; ++cb) O[cb] = O[cb] * alpha;
            u32x4 w0, w1;
            w0.x = pk2(sc[0], sc[1]); w0.y = pk2(sc[2], sc[3]); w0.z = pk2(sc[4], sc[5]); w0.w = pk2(sc[6], sc[7]);
            w1.x = pk2(sc[8], sc[9]); w1.y = pk2(sc[10], sc[11]); w1.z = pk2(sc[12], sc[13]); w1.w = pk2(sc[14], sc[15]);
            const bf16x8 pf0 = __builtin_bit_cast(bf16x8, w0), pf1 = __builtin_bit_cast(bf16x8, w1);
#pragma unroll
            for (int cb = 0; cb < 2; ++cb) { O[cb] = MFMA32(vf[cb], pf0, O[cb]); O[cb] = MFMA32(vf[2 + cb], pf1, O[cb]); }
            if (kb < 4) {
#pragma unroll
                for (int i = 0; i < 4; ++i) { kf[i] = kn[i]; vf[i] = vn[i]; }
            }
        }
#undef DIL_LOAD
        const float lt = swap_sum(lrun), inv = __builtin_amdgcn_rcpf(lt);
#pragma unroll
        for (int cb = 0; cb < 2; ++cb)
#pragma unroll
            for (int j4 = 0; j4 < 4; ++j4) { u32x2 w; w.x = pk2(O[cb][4 * j4] * inv, O[cb][4 * j4 + 1] * inv); w.y = pk2(O[cb][4 * j4 + 2] * inv, O[cb][4 * j4 + 3] * inv); *(GAS u32x2*)(orow + 32 * cb + 8 * j4) = w; }
        if (hi == 0) *lsep = mrun + __log2f(lt);
    }
}

#define XB_TMO      128
#define XB_XCNT(j)  (256  + 64 * (j))
#define XB_XSUB(j)  (1280 + 64 * (j))
#define XB_XGEN(j)  (2304 + 64 * (j))
#define XB_TOP      3328
#define XB_TOPGEN   3392
#define XCD_BAR_WORDS 3456
#define XB_SPIN_CAP (1u << 20)
DI unsigned xb_ld(unsigned* p)              { return __hip_atomic_load(p, __ATOMIC_RELAXED, __HIP_MEMORY_SCOPE_AGENT); }
DI unsigned xb_add(unsigned* p, unsigned v) { return __hip_atomic_fetch_add(p, v, __ATOMIC_RELAXED, __HIP_MEMORY_SCOPE_AGENT); }
DI unsigned xb_xcc_id() { return (unsigned)__builtin_amdgcn_s_getreg((3 << 11) | 20) & 0xFu; }
#define XB_SPIN(cond, bar) do { unsigned _sp = 0; while (cond) { __builtin_amdgcn_s_sleep(1); \
    if ((++_sp & 255u) == 0u) { if (xb_ld(&(bar)[XB_TMO])) break; if (_sp > XB_SPIN_CAP) { atomicAdd(&(bar)[XB_TMO], 1u); break; } } } } while (0)
struct XcdBarrier { unsigned* bar; unsigned x; volatile LAS unsigned* st; };
DI bool is_thread0(int wv) { unsigned z; asm volatile("s_mov_b32 %0, 0" : "=s"(z)); return wv == 0 && __builtin_amdgcn_mbcnt_hi(~0u, __builtin_amdgcn_mbcnt_lo(~0u, z)) == 0u; }
DI XcdBarrier xcd_barrier_post(unsigned* bar, volatile LAS unsigned* st, int wv) {
    XcdBarrier b; b.bar = bar; b.x = xb_xcc_id(); b.st = st;
    if (is_thread0(wv)) (void)xb_add(&bar[XB_XCNT(b.x)], 1u);
    return b;
}
DI void xcd_barrier_complete(unsigned* bar, unsigned x, unsigned& nloc, unsigned& nx) {
    const unsigned G = gridDim.x * gridDim.y * gridDim.z;
    unsigned sum, cnt, mine, sp = 0u;
    for (;;) {
        sum = 0u; cnt = 0u; mine = 0u;
#pragma unroll
        for (unsigned j = 0; j < 16; ++j) { const unsigned c = xb_ld(&bar[XB_XCNT(j)]); sum += c; cnt += (c > 0u) ? 1u : 0u; mine = (j == x) ? c : mine; }
        if (sum == G) break;
        __builtin_amdgcn_s_sleep(1);
        if ((++sp & 255u) == 0u) { if (xb_ld(&bar[XB_TMO])) break; if (sp > XB_SPIN_CAP) { atomicAdd(&bar[XB_TMO], 1u); break; } }
    }
    nloc = mine > 0u ? mine : 1u; nx = cnt > 0u ? cnt : 1u;
}
DI void xcd_barrier(const XcdBarrier& b, int wv) {
    asm volatile("s_waitcnt vmcnt(0)" ::: "memory");
    __syncthreads();
    if (is_thread0(wv)) {
        unsigned* bar = b.bar;
        __builtin_amdgcn_s_waitcnt(0);
        unsigned nloc = b.st[0], nx = b.st[1];
        if (nloc == 0u) { xcd_barrier_complete(bar, b.x, nloc, nx); b.st[0] = nloc; b.st[1] = nx; }
        const unsigned old = xb_add(&bar[XB_XSUB(b.x)], 1u);
        const unsigned gen = old / nloc;
        if (old + 1u == (gen + 1u) * nloc) {
            __builtin_amdgcn_fence(__ATOMIC_RELEASE, "agent");
            asm volatile("s_waitcnt vmcnt(0)" ::: "memory");
            const unsigned og = xb_add(&bar[XB_TOP], 1u);
            const unsigned tg = og / nx;
            if (og + 1u == (tg + 1u) * nx) xb_add(&bar[XB_TOPGEN], 1u);
            else XB_SPIN(xb_ld(&bar[XB_TOPGEN]) == tg, bar);
            __builtin_amdgcn_fence(__ATOMIC_ACQUIRE, "agent");
            xb_add(&bar[XB_XGEN(b.x)], 1u);
            asm volatile("s_waitcnt vmcnt(0)" ::: "memory");
        } else {
            XB_SPIN(xb_ld(&bar[XB_XGEN(b.x)]) == gen, bar);
            __builtin_amdgcn_fence(__ATOMIC_ACQUIRE, "agent");
            asm volatile("s_waitcnt vmcnt(0)" ::: "memory");
        }
    }
    __syncthreads();
}

__global__ void __launch_bounds__(512) fwd_megakernel(Params p) {
    extern __shared__ __attribute__((aligned(16))) unsigned char lds_raw[];
    LAS unsigned char* lds = (LAS unsigned char*)lds_raw;
    LAS unsigned char* scr = lds + LDS_SCR;
    cg::grid_group grid = cg::this_grid();
    LAS unsigned long long* tab = (LAS unsigned long long*)(lds + LDS_SCR + 12288);
    if (threadIdx.x < 25) tab[threadIdx.x] = (unsigned long long)p.in[threadIdx.x];
    if (threadIdx.x == 25) tab[25] = (unsigned long long)p.out;
    if (threadIdx.x == 26) tab[26] = (unsigned long long)p.ws;
    if (threadIdx.x >= 32 && threadIdx.x < 36) ((LAS unsigned*)(lds + LDS_SCR + 13312))[threadIdx.x - 32] = 0u;
    __syncthreads();
#define PIN(k) ((const float*)ldptr(tab + (k)))
    const int G = gridDim.x, NGW = G * 8;
    const int wv = __builtin_amdgcn_readfirstlane((int)threadIdx.x >> 6);
    (void)xcd_barrier_post((unsigned*)p.ws, (volatile LAS unsigned*)(lds + LDS_SCR + 13312), wv);
#define GSYNC() do { XcdBarrier gb_; gb_.bar = (unsigned*)ldptr(tab + 26); gb_.x = xb_xcc_id(); gb_.st = (volatile LAS unsigned*)(lds + LDS_SCR + 13312); xcd_barrier(gb_, wv); } while (0)
#define WSB ((unsigned char*)ldptr(tab + 26))
#define cosT ((float*)(WSB + WS_ROPE_C))
#define sinT ((float*)(WSB + WS_ROPE_S))
#define LSE ((float*)(WSB + WS_LSE))
#define WPT(off) ((bf16_t*)(WSB + WS_W + (off)))
#define WQK WPT(W_QK)
#define WV WPT(W_V)
#define WO WPT(W_O)
#define WXQ WPT(W_XQ)
#define WXK WPT(W_XK)
#define WXV WPT(W_XV)
#define WXO WPT(W_XO)
#define WUP WPT(W_UP)
#define WDN WPT(W_DN)
#define MEMN WPT(W_MEMN)
#define KMEM WPT(W_KMEM)
#define VMEM WPT(W_VMEM)
#define BT1 WPT(W_BT1)
#define BT2 WPT(W_BT2)
#define ACT ((bf16_t*)(WSB + WS_ACT))
#define BIG (WSB + WS_BIG)
#define X ((float*)ldptr(tab + 25))

    for (int l = 0; l < 2; ++l) {
        {
            const int tid = get_tid(wv);
            const int lane = tid & 63, wave = __builtin_amdgcn_readfirstlane(tid >> 6), gw = blockIdx.x * 8 + wave;
            LAS float* tscr = (LAS float*)(lds + wave * 16384);
            const float* w_in = PIN(4) + (size_t)l * 1024 * 3072; const float* w_out = PIN(5) + (size_t)l * 1024 * 1024; const float* w_xq = PIN(11) + (size_t)l * 1024 * 1024;
            const float* w_xkv = PIN(12) + (size_t)l * 1024 * 2048; const float* w_xo = PIN(13) + (size_t)l * 1024 * 1024; const float* w_up = PIN(14) + (size_t)l * 1024 * DFF2; const float* w_dn = PIN(17) + (size_t)l * DFF * 1024;
            bf16_t* const wqk = WQK; bf16_t* const wo = WO; bf16_t* const wxk = WXK; bf16_t* const wxo = WXO; bf16_t* const wup = WUP; bf16_t* const wdn = WDN; bf16_t* const wxq = WXQ; bf16_t* const memn = MEMN; bf16_t* const act = ACT;
            float* const xo = X; float* const cosp = cosT; float* const sinp = sinT;
            const float* const mem_p = PIN(2); const float* const mem_s = PIN(3); const float* const g_mem = PIN(20) + l * DM; const float* const x_p = PIN(0); const float* const x_s = PIN(1); const float* const g_pre0 = PIN(18);
            constexpr int I_IN = 16 * 96, I_O = 16 * 32, I_XKV = 16 * 64, I_XO = 16 * 32, I_UP = 16 * 176, I_DN = 44 * 32;
            constexpr int NIT = I_IN + I_O + I_XKV + I_XO + I_UP + I_DN;
            for (int it = gw; it < NIT; it += NGW) {
                int q = it;
                if (q < I_IN) { transpose_item(w_in, 3072, q / 96, (q % 96) * 32, wqk, 1024, tscr, lane, DrowWin{}); continue; } q -= I_IN;
                if (q < I_O) { transpose_item(w_out, 1024, q / 32, (q % 32) * 32, wo, 1024, tscr, lane, DrowId{0}); continue; } q -= I_O;
                if (q < I_XKV) { transpose_item(w_xkv, 2048, q / 64, (q % 64) * 32, wxk, 1024, tscr, lane, DrowId{0}); continue; } q -= I_XKV;
                if (q < I_XO) { transpose_item(w_xo, 1024, q / 32, (q % 32) * 32, wxo, 1024, tscr, lane, DrowId{0}); continue; } q -= I_XO;
                if (q < I_UP) { transpose_item(w_up, DFF2, q / 176, (q % 176) * 32, wup, 1024, tscr, lane, DrowUp{}); continue; } q -= I_UP;
                transpose_item(w_dn, 1024, q / 32, (q % 32) * 32, wdn, DFF, tscr, lane, DrowId{0});
            }
            for (int i = blockIdx.x * 512 + tid; i < 1024 * 1024 / 8; i += G * 512) { const f32x4 a = ((const GAS f32x4*)w_xq)[2 * i], b = ((const GAS f32x4*)w_xq)[2 * i + 1];
                u32x4 w; w.x = pk2(a.x, a.y); w.y = pk2(a.z, a.w); w.z = pk2(b.x, b.y); w.w = pk2(b.z, b.w); ((GAS u32x4*)wxq)[i] = w; }
            for (int row = gw; row < 1536; row += NGW) { const float* src = row < 1024 ? mem_p + (size_t)row * DM : mem_s + (size_t)(row - 1024) * DM;
                f32x4 v[4];
#pragma unroll
                for (int j = 0; j < 4; ++j) v[j] = ((const GAS f32x4*)src)[lane + 64 * j];
                norm_row_bf16(v, g_mem, memn + (size_t)row * DM, lane); }
            if (l == 0) {
                for (int row = gw; row < NTOK; row += NGW) { const float* src = row < TOK_P ? x_p + (size_t)row * DM : x_s + (size_t)(row - TOK_P) * DM;
                    f32x4 v[4];
#pragma unroll
                    for (int j = 0; j < 4; ++j) v[j] = ((const GAS f32x4*)src)[lane + 64 * j];
                    norm_row_bf16(v, g_pre0, act + (size_t)row * DM, lane); }
                for (int i = blockIdx.x * 512 + tid; i < 16384 * 32; i += G * 512) {
                    const int pos = i >> 5, f = i & 31; const double ang = (double)pos * p.inv_freq[f];
                    const double k = rint(ang * 0.15915494309189535); double rd = fma(-k, 6.283185307179586, ang); rd = fma(-k, 2.4492935982947064e-16, rd);
                    const double x2 = rd * rd; double sn = 1.0, cs = 1.0;
#pragma unroll
                    for (int n = 14; n >= 1; --n) { sn = 1.0 - sn * x2 * (1.0 / (double)((2 * n) * (2 * n + 1))); cs = 1.0 - cs * x2 * (1.0 / (double)((2 * n - 1) * (2 * n))); }
                    cosp[i] = (float)cs; sinp[i] = (float)(sn * rd);
                }
            }
        }
        if (l == 0) grid.sync(); else GSYNC();

        const float qscale = 0.125f * LOG2E;

        for (int grp = 0; grp < 2; ++grp) {
            const int row0 = grp == 0 ? 0 : TOK_P, rows = grp == 0 ? TOK_P : TOK_S, nb = grp == 0 ? 4 : 2, S = grp == 0 ? 4096 : 16384;
            bf16_t* QK = (bf16_t*)BIG; bf16_t* VT = (bf16_t*)(BIG + 128 * MiB); bf16_t* VT1 = (bf16_t*)(BIG + 192 * MiB); bf16_t* VT2 = (bf16_t*)(BIG + 224 * MiB);
            const bf16_t* XNg = ACT + (size_t)row0 * DM;
            {
                pg8::Sched Sc;
                if (grp == 0) {
                    Sc.init(MEMN, 1024, 6, WXK, 1024, 4, 1024, 0, 0, 0, 128); pg8::gemm_phase(wv, lds, scr, Sc, pg8::EpiBf16{KMEM, 1024, 256 * 1024, 0, 1.0f});
                    Sc.init(MEMN, 1024, 6, WXV, 1024, 4, 1024, 0, 0, 0, 160); pg8::gemm_phase(wv, lds, scr, Sc, pg8::EpiBf16{VMEM, 1024, 256 * 1024, 0, 1.0f});
                }
                Sc.init(XNg, 1024, rows / 256, WQK, 1024, 8, 1024); pg8::gemm_phase(wv, lds, scr, Sc, pg8::EpiRope{QK, cosT, sinT, S - 1, qscale});
                Sc.init(WV, 1024, 2, XNg, 1024, rows / 256, 1024); pg8::gemm_phase(wv, lds, scr, Sc, pg8::EpiBf16{VT, rows, 256L * rows, 0, 1.0f});
                Sc.init(WV + 512 * 1024, 1024, 2, XNg, 1024, rows / 256, 1024, 0, 0, 0, 64); pg8::gemm_phase(wv, lds, scr, Sc, pg8::EpiVtd{VT + (size_t)512 * rows, rows});
                Sc.init(WV + 512 * 1024, 1024, 2, XNg, 4 * 1024, rows / 256, 1024, 1, S, 4); pg8::gemm_phase(wv, lds, scr, Sc, pg8::EpiVtd{VT1, rows});
                Sc.init(WV + 512 * 1024, 1024, 2, XNg, 16 * 1024, rows / 256, 1024, 1, S, 16, 128); pg8::gemm_phase(wv, lds, scr, Sc, pg8::EpiVtd{VT2, rows});
            }
            GSYNC();
            if (grp == 0) {
                pg8::Sched Sc;
                Sc.init(KMEM, 1024, 24, WXQ, 1024, 4, 256, 3); pg8::gemm_phase(wv, lds, scr, Sc, pg8::EpiBf16{BT1, 1024, 262144, 0, 0.0625f * LOG2E});
                Sc.init(WXO, 1024, 4, VMEM, 1024, 24, 256, 4, 0, 0, 128); pg8::gemm_phase(wv, lds, scr, Sc, pg8::EpiBf16{BT2, 1024, 256 * 1024, 1, 1.0f});
            }
            bf16_t* OUTg = ACT + (size_t)row0 * DM; float* LSEg = LSE + (size_t)row0 * 8;
            diff_attn_phase(wv, lds, QK, VT, rows, nb, S, OUTg, PIN(6) + l * 64, PIN(7) + l * 64, PIN(8) + l * 64, PIN(9) + l * 64, p.lambda_init[0], p.lambda_init[1], l, PIN(10) + l * 128);
            dil_phase(wv, QK, VT + (size_t)512 * rows, rows, nb, S, 1, 0, OUTg, LSEg);
            GSYNC();
            dil_phase(wv, QK, VT1, rows, nb, S, 4, 1, OUTg, LSEg);
            GSYNC();
            dil_phase(wv, QK, VT2, rows, nb, S, 16, 2, OUTg, LSEg);
            GSYNC();
        }
        { pg8::Sched Sc; Sc.init(ACT, 1024, NTOK / 256, WO, 1024, 4, 1024); pg8::gemm_phase(wv, lds, scr, Sc, pg8::EpiBf16{(bf16_t*)BIG, 1024, 256 * 1024, 0, 1.0f}); }
        GSYNC();
        if (l == 0) post_pass(wv, (const bf16_t*)BIG, 0, X, PIN(19), PIN(21), ACT, 0, NTOK, PIN(0), PIN(1));
        else post_pass(wv, (const bf16_t*)BIG, 0, X, PIN(19) + DM, PIN(21) + DM, ACT, 0, NTOK);
        GSYNC();
        { pg8::Sched Sc; Sc.init(ACT, 1024, NTOK / 256, BT1, 1024, 4, 1024, 2); pg8::gemm_phase(wv, lds, scr, Sc, pg8::EpiSoftmax{(bf16_t*)BIG, 1024}); }
        GSYNC();
        { pg8::Sched Sc; Sc.init((const bf16_t*)BIG, 1024, NTOK / 256, BT2, 1024, 4, 1024, 2); pg8::gemm_phase(wv, lds, scr, Sc, pg8::EpiBf16{(bf16_t*)(BIG + 96 * MiB), 1024, 256 * 1024, 0, 1.0f}); }
        GSYNC();
        post_pass(wv, (const bf16_t*)(BIG + 96 * MiB), 0, X, PIN(22) + l * DM, PIN(23) + l * DM, ACT, 0, NTOK);
        GSYNC();
        {
            pg8::Sched Sc; Sc.init(ACT, 1024, 194, WUP, 1024, 22, 1024, 5);
            pg8::gemm_phase(wv, lds, scr, Sc, pg8::EpiConvGate{(bf16_t*)BIG, PIN(15) + (size_t)l * 3 * DFF2, PIN(16) + (size_t)l * DFF2, -1, NTOK}); }
        GSYNC();
        for (int c = 0; c < 4; ++c) {
            const int r0 = c * 16384;
            for (int ph = 0; ph < 2; ++ph) {
                if (c > 0 && ((ph == 0) == ((blockIdx.x & 1) != 0)))
                    post_pass(wv, (bf16_t*)(BIG + (264 + 32 * ((c - 1) & 1)) * MiB), r0 - 16384, X, PIN(24) + l * DM, l == 0 ? PIN(18) + DM : nullptr, ACT, r0 - 16384, r0);
                if (ph == 0 && c < 3) { pg8::Sched Sc; Sc.init((bf16_t*)BIG + (size_t)r0 * DFF, DFF, 64, WDN, DFF, 4, DFF);
                    pg8::gemm_phase(wv, lds, scr, Sc, pg8::EpiBf16{(bf16_t*)(BIG + (264 + 32 * (c & 1)) * MiB), 1024, 256 * 1024, 0, 1.0f}); }
            }
            GSYNC();
        }
    }
}

extern "C" void kernel_launch(void* const* d_in, const int* in_sizes, int n_in, void* d_out, int out_size, void* d_ws, size_t ws_size, hipStream_t stream) {
    static int grid_blocks = 0;
    if (grid_blocks == 0) {
        if (n_in != 25 || out_size != NTOK * DM || ws_size < WS_END) { fprintf(stderr, "kernel_launch: unexpected shapes (n_in %d out %d ws %zu)\n", n_in, out_size, ws_size); grid_blocks = -1; return; }
        int dev = 0, cus = 0, per_cu = 0;
        hipGetDevice(&dev);
        hipDeviceGetAttribute(&cus, hipDeviceAttributeMultiprocessorCount, dev);
        hipFuncSetAttribute((const void*)fwd_megakernel, hipFuncAttributeMaxDynamicSharedMemorySize, LDS_BYTES);
        hipOccupancyMaxActiveBlocksPerMultiprocessor(&per_cu, (const void*)fwd_megakernel, 512, LDS_BYTES);
        if (per_cu < 1) per_cu = 1;
        grid_blocks = cus * per_cu;
        (void)hipGetLastError();
    }
    if (grid_blocks < 0) return;
    Params p{};
    for (int i = 0; i < 25; ++i) p.in[i] = (const float*)d_in[i];
    p.out = (float*)d_out; p.ws = (unsigned char*)d_ws;
    for (int i = 0; i < 32; ++i) p.inv_freq[i] = 1.0 / std::pow(10000.0, (double)(2 * i) / 64.0);
    p.lambda_init[0] = (float)(0.8 - 0.6 * std::exp(-0.3 * 0.0)); p.lambda_init[1] = (float)(0.8 - 0.6 * std::exp(-0.3 * 1.0));
    (void)hipMemsetAsync(d_ws, 0, 65536, stream);
    void* args[] = {&p};
    hipError_t e = hipLaunchCooperativeKernel((const void*)fwd_megakernel, dim3(grid_blocks), dim3(512), args, LDS_BYTES, stream);
    if (e != hipSuccess) fprintf(stderr, "cooperative launch failed: %s (grid %d)\n", hipGetErrorString(e), grid_blocks);
}
```
